# Optimizing an MI355X kernel written in HIP

```python
import math
import jax, jax.numpy as jnp
from jax import lax
import numpy as np

D_MODEL = 2048
BATCH = 2
SEQ = 4096
DEPTH = 4

N_MIXERS = 2
N_POOL_LAYERS = (DEPTH + 1) // 2
N_FOX_LAYERS = DEPTH // 2

POOL_WINDOWS = (2, 4, 8, 16)
N_POOL_GROUPS = len(POOL_WINDOWS)
POOL_GROUP = D_MODEL // N_POOL_GROUPS

FOX_HEAD_DIM = 128
FOX_HEADS = D_MODEL // FOX_HEAD_DIM
Q_BLOCK = 128

D_FF = 5632
FFN_RESIDUAL_WEIGHT = 0.5
RMS_EPS = 1e-6
NEG_LARGE = -1e30

kernel_name = "hybrid_pool_fox_macaron"


def rms_norm(x, g):
    xf = x.astype(jnp.float32)
    y = xf * lax.rsqrt(jnp.mean(xf * xf, axis=-1, keepdims=True) + RMS_EPS)
    return (y * g.astype(jnp.float32)).astype(x.dtype)


def swiglu(x, w_gate, w_up, w_down):
    return (jax.nn.silu(x @ w_gate) * (x @ w_up)) @ w_down


def causal_trailing_mean(xg, window):
    T = xg.shape[1]
    c = jnp.pad(jnp.cumsum(xg.astype(jnp.float32), axis=1), ((0, 0), (1, 0), (0, 0)))
    hi = c[:, 1:]
    lo = jnp.pad(c[:, :T + 1 - window], ((0, 0), (window - 1, 0), (0, 0)))
    count = jnp.minimum(jnp.arange(1, T + 1), window).astype(jnp.float32)[None, :, None]
    return (hi - lo) / count


def pool_mixer(h, w_groups, scale):
    B, T, D = h.shape
    hg = h.reshape(B, T, N_POOL_GROUPS, POOL_GROUP)
    pooled = jnp.stack([causal_trailing_mean(hg[:, :, g], w) for g, w in enumerate(POOL_WINDOWS)], axis=2)
    diff = (pooled - hg.astype(jnp.float32)).astype(h.dtype)
    y = jnp.einsum('btgc,gcd->btgd', diff, w_groups).reshape(B, T, D)
    return y * scale


def fox_mixer(h, w_in, b_f, q_gain, k_gain, w_out):
    B, T, D = h.shape
    proj = h @ w_in
    q = proj[..., :D].reshape(B, T, FOX_HEADS, FOX_HEAD_DIM)
    k = proj[..., D:2 * D].reshape(B, T, FOX_HEADS, FOX_HEAD_DIM)
    v = proj[..., 2 * D:3 * D].reshape(B, T, FOX_HEADS, FOX_HEAD_DIM)
    f_logit = proj[..., 3 * D:]
    q = rms_norm(q, q_gain) * (1.0 / math.sqrt(FOX_HEAD_DIM))
    k = rms_norm(k, k_gain)
    log_f = jax.nn.log_sigmoid((f_logit + b_f).astype(jnp.float32))
    F = jnp.cumsum(log_f, axis=1).transpose(0, 2, 1)
    q = q.transpose(0, 2, 1, 3)
    k = k.transpose(0, 2, 1, 3)
    v = v.transpose(0, 2, 1, 3)
    nb = T // Q_BLOCK
    q_blocks = q.reshape(B, FOX_HEADS, nb, Q_BLOCK, FOX_HEAD_DIM).transpose(2, 0, 1, 3, 4)
    F_blocks = F.reshape(B, FOX_HEADS, nb, Q_BLOCK).transpose(2, 0, 1, 3)
    starts = jnp.arange(nb, dtype=jnp.int32) * Q_BLOCK
    kpos = jnp.arange(T, dtype=jnp.int32)

    def attend_block(args):
        qi, Fi, s0 = args
        logits = jnp.einsum('bhqd,bhkd->bhqk', qi, k).astype(jnp.float32)
        logits = logits + Fi[..., :, None] - F[..., None, :]
        qpos = s0 + jnp.arange(Q_BLOCK, dtype=jnp.int32)
        mask = kpos[None, :] <= qpos[:, None]
        logits = jnp.where(mask, logits, NEG_LARGE)
        p = jax.nn.softmax(logits, axis=-1).astype(v.dtype)
        return jnp.einsum('bhqk,bhkd->bhqd', p, v)

    o = lax.map(attend_block, (q_blocks, F_blocks, starts))
    o = o.transpose(1, 0, 3, 2, 4).reshape(B, T, D)
    return o @ w_out


def setup_inputs(seed: int = 0) -> dict:
    key = jax.random.key(seed)
    ks = iter(jax.random.split(key, 32))
    nrm = lambda shape, s: jax.random.normal(next(ks), shape, jnp.float32) * s
    gain = lambda shape: 1.0 + nrm(shape, 0.02)
    D, F, H = D_MODEL, D_FF, FOX_HEADS
    return {
        "x": nrm((BATCH, SEQ, D), 1.0),
        "ffn1_norm": gain((DEPTH, D)),
        "ffn1_w_gate": nrm((DEPTH, D, F), D ** -0.5),
        "ffn1_w_up": nrm((DEPTH, D, F), D ** -0.5),
        "ffn1_w_down": nrm((DEPTH, F, D), F ** -0.5),
        "mix_norm": gain((DEPTH, D)),
        "pool_w": nrm((N_POOL_LAYERS, N_POOL_GROUPS, POOL_GROUP, POOL_GROUP), POOL_GROUP ** -0.5),
        "pool_scale": 1.0 + nrm((N_POOL_LAYERS, D), 0.1),
        "fox_w_in": nrm((N_FOX_LAYERS, D, 3 * D + H), D ** -0.5),
        "fox_b_f": nrm((N_FOX_LAYERS, H), 0.1),
        "fox_q_gain": gain((N_FOX_LAYERS, FOX_HEAD_DIM)),
        "fox_k_gain": gain((N_FOX_LAYERS, FOX_HEAD_DIM)),
        "fox_w_out": nrm((N_FOX_LAYERS, D, D), D ** -0.5),
        "ffn2_norm": gain((DEPTH, D)),
        "ffn2_w_gate": nrm((DEPTH, D, F), D ** -0.5),
        "ffn2_w_up": nrm((DEPTH, D, F), D ** -0.5),
        "ffn2_w_down": nrm((DEPTH, F, D), F ** -0.5),
    }


def reference(x, ffn1_norm, ffn1_w_gate, ffn1_w_up, ffn1_w_down, mix_norm, pool_w, pool_scale,
              fox_w_in, fox_b_f, fox_q_gain, fox_k_gain, fox_w_out,
              ffn2_norm, ffn2_w_gate, ffn2_w_up, ffn2_w_down):
    for i in range(DEPTH):
        x = x + FFN_RESIDUAL_WEIGHT * swiglu(rms_norm(x, ffn1_norm[i]), ffn1_w_gate[i], ffn1_w_up[i], ffn1_w_down[i])
        h = rms_norm(x, mix_norm[i])
        j = i // N_MIXERS
        if i % N_MIXERS == 0:
            x = x + pool_mixer(h, pool_w[j], pool_scale[j])
        else:
            x = x + fox_mixer(h, fox_w_in[j], fox_b_f[j], fox_q_gain[j], fox_k_gain[j], fox_w_out[j])
        x = x + FFN_RESIDUAL_WEIGHT * swiglu(rms_norm(x, ffn2_norm[i]), ffn2_w_gate[i], ffn2_w_up[i], ffn2_w_down[i])
    return x
```

```cpp
#include <hip/hip_runtime.h>
#include <hip/hip_bf16.h>
#include <cstdio>
#include <cstdint>

__device__ __forceinline__ int opaque_tid() { int t = (int)threadIdx.x; asm volatile("" : "+v"(t)); return t; }

namespace pg8 {
#define PG8_LAS __attribute__((address_space(3)))
typedef unsigned short bf16_t;
typedef short bf16x8 __attribute__((ext_vector_type(8)));
typedef float f32x4 __attribute__((ext_vector_type(4)));
typedef unsigned u32x4 __attribute__((ext_vector_type(4)));
typedef unsigned u32x2 __attribute__((ext_vector_type(2)));
constexpr int BM = 256, BK = 64, HALF = 128, HTB = HALF * BK * 2  , STAGE_BYTES = 8 * HTB, NXCD = 8, WGM = 8;

__host__ __device__ __forceinline__ int lds_byte(int r, int c) { const int st = (r >> 4) * 2 + (c >> 5), rr = r & 15, cc = c & 31, ob = rr * 64 + cc * 2; return st * 1024 + (ob ^ (((ob >> 9) & 1) << 5)); }
__host__ __device__ __forceinline__ void stage_rc(int b, int& R, int& C) { const int st = b / 1024, sb = b % 1024, swz = sb ^ (((sb >> 9) & 1) << 5); R = (st >> 1) * 16 + swz / 64; C = (st & 1) * 32 + (swz % 64) / 2; }
__host__ __device__ __forceinline__ int perm32(int rho) { const int n = rho >> 4, i = rho & 15; return 8 * (i >> 2) + 4 * n + (i & 3); }

struct Unit { int pm, pn; };
struct Gemm { const bf16_t* A; const bf16_t* Bt; int M, N, K; int lda; int a_shift; int a_gbytes; };

struct StaticOrder {
    int nM, nN, nwg, G, c;
    __host__ __device__ void init(int M, int N, int G_, int c_) { nM = M / BM; nN = N / BM; nwg = nM * nN; G = G_; c = c_; }
    __host__ __device__ bool next(int i, Unit& u) const {
        const long L = (long)i * G + c; if (L >= nwg) return false;
        int wgid = (int)L; { const int q = nwg / NXCD, r = nwg % NXCD, xcd = wgid % NXCD, off = wgid / NXCD; wgid = (xcd < r ? xcd * (q + 1) : r * (q + 1) + (xcd - r) * q) + off; }
        const int nig = WGM * nN, gid = wgid / nig, fm = gid * WGM, gsz = (nM - fm) < WGM ? (nM - fm) : WGM;
        u.pm = fm + ((wgid % nig) % gsz); u.pn = (wgid % nig) / gsz; return true;
    }
    __device__ __forceinline__ void a_ready(const Unit&) const {}
    __device__ __forceinline__ void done(const Unit&) const {}
};

__device__ __forceinline__ unsigned cvt_pk_bf16(float lo, float hi) { unsigned r; asm volatile("v_cvt_pk_bf16_f32 %0, %1, %2" : "=v"(r) : "v"(lo), "v"(hi)); return r; }

constexpr int DM = 2048;
constexpr int SSQ_PARTS = 32;
constexpr float RMS_EPS = 1e-6f;
__device__ __forceinline__ float row_rstd(const float* ssq, int row, int fq) {
    const f32x4* p = (const f32x4*)(ssq + (size_t)row * SSQ_PARTS + fq * 8);
    const f32x4 a = p[0], b = p[1];
    float s = ((a[0] + a[1]) + (a[2] + a[3])) + ((b[0] + b[1]) + (b[2] + b[3]));
    s += __shfl_xor(s, 16); s += __shfl_xor(s, 32);
    return 1.0f / sqrtf(s * (1.0f / DM) + RMS_EPS);
}

struct EpiSwiglu {
    static constexpr bool PERM = true, AFTER_DRAIN = false;
    bf16_t* H; int ldh; const float* ssq;
    __device__ __forceinline__ void operator()(const f32x4 (&acc)[2][2][4][2], const Unit& u, int wr, int wc, int fr, int fq) const {
        const int row0 = u.pm * BM + wr * 64 + fr, col0 = u.pn * HALF + wc * 32 + 8 * fq;
#pragma unroll
        for (int ai = 0; ai < 2; ++ai)
#pragma unroll
            for (int m = 0; m < 4; ++m) {
                const int row = row0 + ai * HALF + m * 16;
                const float rs = row_rstd(ssq, row, fq);
                float o[8];
#pragma unroll
                for (int n = 0; n < 2; ++n)
#pragma unroll
                    for (int j = 0; j < 4; ++j) {
                        const float g = acc[ai][0][m][n][j] * rs, up = acc[ai][1][m][n][j] * rs;
                        const float e = __builtin_amdgcn_exp2f(g * -1.4426950408889634f);
                        o[n * 4 + j] = g * up * __builtin_amdgcn_rcpf(1.0f + e);
                    }
                u32x4 w; w.x = cvt_pk_bf16(o[0], o[1]); w.y = cvt_pk_bf16(o[2], o[3]); w.z = cvt_pk_bf16(o[4], o[5]); w.w = cvt_pk_bf16(o[6], o[7]);
                *(u32x4*)(H + (size_t)row * ldh + col0) = w;
            }
    }
};

template <bool HALFSTEP  > struct EpiResid {
    static constexpr bool PERM = false, AFTER_DRAIN = false;
    const float* xin; float* xout; const float* cvec; const float* gain; bf16_t* xg; float* ssq;
    __device__ __forceinline__ void operator()(const f32x4 (&acc)[2][2][4][2], const Unit& u, int wr, int wc, int fr, int fq) const {
        const int row0 = u.pm * BM + wr * 64 + fr, col0 = u.pn * BM + wc * 32 + 4 * fq;
        f32x4 cv[2][2], gv[2][2];
#pragma unroll
        for (int bj = 0; bj < 2; ++bj)
#pragma unroll
            for (int n = 0; n < 2; ++n) {
                const int c = col0 + bj * HALF + n * 16;
                constexpr float cs = HALFSTEP ? 0.5f : 1.0f;
                cv[bj][n] = cvec ? *(const f32x4*)(cvec + c) * cs : (f32x4){cs, cs, cs, cs};
                gv[bj][n] = gain ? *(const f32x4*)(gain + c) : (f32x4){0.f, 0.f, 0.f, 0.f};
            }
#pragma unroll
        for (int ai = 0; ai < 2; ++ai)
#pragma unroll
            for (int m = 0; m < 4; ++m) {
                const int row = row0 + ai * HALF + m * 16;
                float sq = 0.f;
#pragma unroll
                for (int bj = 0; bj < 2; ++bj)
#pragma unroll
                    for (int n = 0; n < 2; ++n) {
                        const size_t off = (size_t)row * DM + col0 + bj * HALF + n * 16;
                        const f32x4 xo = *(const f32x4*)(xin + off);
                        const f32x4 xn = xo + acc[ai][bj][m][n] * cv[bj][n];
                        *(f32x4*)(xout + off) = xn;
                        sq += (xn[0] * xn[0] + xn[1] * xn[1]) + (xn[2] * xn[2] + xn[3] * xn[3]);
                        if (gain) { const f32x4 t = xn * gv[bj][n]; u32x2 w; w.x = cvt_pk_bf16(t[0], t[1]); w.y = cvt_pk_bf16(t[2], t[3]); *(u32x2*)(xg + off) = w; }
                    }
                sq += __shfl_xor(sq, 16); sq += __shfl_xor(sq, 32);
                if (gain && fq == 0) ssq[(size_t)row * SSQ_PARTS + u.pn * 4 + wc] = sq;
            }
    }
};

struct EpiQKV {
    static constexpr bool PERM = true, AFTER_DRAIN = false;
    bf16_t* Q; size_t tstride; const float* ssq;
    __device__ __forceinline__ void operator()(const f32x4 (&acc)[2][2][4][2], const Unit& u, int wr, int wc, int fr, int fq) const {
        const int which = u.pn >> 3, hp = u.pn & 7;
        bf16_t* base = Q + (size_t)which * tstride;
        const int row0 = u.pm * BM + wr * 64 + fr, d0 = wc * 32 + 8 * fq;
#pragma unroll
        for (int ai = 0; ai < 2; ++ai)
#pragma unroll
            for (int m = 0; m < 4; ++m) {
                const int row = row0 + ai * HALF + m * 16;
                const float rs = row_rstd(ssq, row, fq);
                const int b = row >> 12, t = row & 4095;
#pragma unroll
                for (int bj = 0; bj < 2; ++bj) {
                    const int h = 2 * hp + bj;
                    const f32x4 v0 = acc[ai][bj][m][0] * rs, v1 = acc[ai][bj][m][1] * rs;
                    u32x4 w; w.x = cvt_pk_bf16(v0[0], v0[1]); w.y = cvt_pk_bf16(v0[2], v0[3]); w.z = cvt_pk_bf16(v1[0], v1[1]); w.w = cvt_pk_bf16(v1[2], v1[3]);
                    *(u32x4*)(base + (((size_t)(b * 16 + h) * 4096 + t) * 128 + d0)) = w;
                }
            }
    }
};

template <class Epi, class Sched, bool ALIGN_EPI = false, bool SP2 = false>
__device__ __forceinline__ void gemm_phase(PG8_LAS unsigned char* lds, const Gemm g, const Sched& S, const Epi& E) {
    const int tid = opaque_tid(), wid = __builtin_amdgcn_readfirstlane(tid >> 6), lane = tid & 63, wr = wid >> 2, wc = wid & 3, fr = lane & 15, fq = lane >> 4;
    const int K = g.K, nt = K / BK;
    unsigned voffA[2], voffB[2];
#pragma unroll
    for (int i = 0; i < 2; ++i) { int R, C; stage_rc(tid * 16 + i * 8192, R, C); const int Rb = Epi::PERM ? ((R & ~31) + perm32(R & 31)) : R;
        voffA[i] = (unsigned)(R * g.lda + C) * 2u; voffB[i] = (unsigned)(Rb * K + C) * 2u; }
    const size_t kstep = (size_t)(BK * 2);
    const size_t hstepA = (size_t)HALF * g.lda * 2, hstepB = (size_t)HALF * K * 2;
    const size_t tstepA = 2 * hstepA, tstepB = 2 * hstepB;
#define PG8_AOFF(u) ((size_t)(u).pm * tstepA + (size_t)((u).pn >> g.a_shift) * (size_t)g.a_gbytes)
    const unsigned ldsw = (unsigned)wid * 1024u;
    const int aoff = lds_byte(wr * 64 + fr, fq * 8), boff = lds_byte(wc * 32 + fr, fq * 8);
#define PG8_SA(b, h) (((b) * 2 + (h)) * HTB)
#define PG8_SB(b, h) ((4 + (b) * 2 + (h)) * HTB)
#define PG8_STAGE(bufoff, gbase, voff) do { _Pragma("unroll") for (int _i = 0; _i < 2; ++_i) \
        __builtin_amdgcn_global_load_lds((const unsigned*)((const char*)(gbase) + (voff)[_i]), (PG8_LAS unsigned*)(lds + (bufoff) + ldsw + _i * 8192), 16, 0, 0); } while (0)
#define PG8_LDA(dst, b, h) do { _Pragma("unroll") for (int m = 0; m < 4; ++m) _Pragma("unroll") for (int k = 0; k < 2; ++k) dst[m][k] = *(const PG8_LAS bf16x8*)(lds + PG8_SA(b, h) + aoff + m * 2048 + k * 1024); } while (0)
#define PG8_LDB(dst, b, h) do { _Pragma("unroll") for (int n = 0; n < 2; ++n) _Pragma("unroll") for (int k = 0; k < 2; ++k) dst[n][k] = *(const PG8_LAS bf16x8*)(lds + PG8_SB(b, h) + boff + n * 2048 + k * 1024); } while (0)
#define PG8_MMA(ai, bj, At, Bt) do { __builtin_amdgcn_s_setprio(1); _Pragma("unroll") for (int m = 0; m < 4; ++m) _Pragma("unroll") for (int n = 0; n < 2; ++n) _Pragma("unroll") for (int k = 0; k < 2; ++k) \
        acc[ai][bj][m][n] = __builtin_amdgcn_mfma_f32_16x16x32_bf16(Bt[n][k], At[m][k], acc[ai][bj][m][n], 0, 0, 0); __builtin_amdgcn_s_setprio(0); } while (0)
#define PG8_WAIT_V(n) asm volatile("s_waitcnt vmcnt(" #n ")" ::: "memory")
#define PG8_WAIT_L(n) asm volatile("s_waitcnt lgkmcnt(" #n ")" ::: "memory")
#define PG8_BAR __builtin_amdgcn_s_barrier()
#define PG8_SCHED __builtin_amdgcn_sched_barrier(0)
    Unit cur, nxt; int ui = 0;
    if (!S.next(0, cur)) return;
    f32x4 acc[2][2][4][2];
#pragma unroll
    for (int a = 0; a < 2; ++a)
#pragma unroll
        for (int b = 0; b < 2; ++b)
#pragma unroll
            for (int m = 0; m < 4; ++m)
#pragma unroll
                for (int n = 0; n < 2; ++n) acc[a][b][m][n] = (f32x4){0.f, 0.f, 0.f, 0.f};
    bf16x8 At[4][2], B0[2][2], B1[2][2];
    const char* cA = (const char*)g.A + PG8_AOFF(cur); const char* cB = (const char*)g.Bt + (size_t)cur.pn * tstepB;
    S.a_ready(cur);
    if constexpr (SP2) {
        PG8_STAGE(PG8_SB(0, 0), cB, voffB); PG8_STAGE(PG8_SB(0, 1), cB + hstepB, voffB); PG8_STAGE(PG8_SA(0, 0), cA, voffA); PG8_STAGE(PG8_SA(0, 1), cA + hstepA, voffA);
        if (wr == 1) PG8_BAR;
        PG8_WAIT_V(2); PG8_BAR;
        PG8_STAGE(PG8_SB(1, 0), cB + kstep, voffB); PG8_STAGE(PG8_SA(1, 0), cA + kstep, voffA); PG8_STAGE(PG8_SB(1, 1), cB + hstepB + kstep, voffB);
        PG8_WAIT_V(6); PG8_BAR;
    } else {
        PG8_STAGE(PG8_SB(0, 0), cB, voffB); PG8_STAGE(PG8_SA(0, 0), cA, voffA); PG8_STAGE(PG8_SB(0, 1), cB + hstepB, voffB); PG8_STAGE(PG8_SA(0, 1), cA + hstepA, voffA);
        if (wr == 1) PG8_BAR;
        PG8_WAIT_V(4); PG8_BAR;
        PG8_STAGE(PG8_SB(1, 0), cB + kstep, voffB); PG8_STAGE(PG8_SA(1, 0), cA + kstep, voffA); PG8_STAGE(PG8_SB(1, 1), cB + hstepB + kstep, voffB);
        PG8_WAIT_V(6); PG8_BAR;
    }
    for (;;) {
        const bool has_next = S.next(ui + 1, nxt);
        const char* nA = has_next ? (const char*)g.A + PG8_AOFF(nxt) : cA; const char* nB = has_next ? (const char*)g.Bt + (size_t)nxt.pn * tstepB : cB;
        for (int t = 0; t < nt; t += 2) {
            const bool last = (t == nt - 2);
            const char* a1 = cA + (size_t)(t + 1) * kstep;
            const char* a2 = last ? nA : cA + (size_t)(t + 2) * kstep; const char* b2 = last ? nB : cB + (size_t)(t + 2) * kstep;
            const char* a3 = a2 + kstep; const char* b3 = b2 + kstep;
            if (last && has_next) S.a_ready(nxt);
            if constexpr (SP2) {
            PG8_LDB(B0, 0, 0); PG8_LDB(B1, 0, 1); PG8_SCHED; PG8_LDA(At, 0, 0); PG8_STAGE(PG8_SA(1, 1), a1 + hstepA, voffA);
            PG8_WAIT_V(8); PG8_WAIT_L(0); PG8_BAR; PG8_MMA(0, 0, At, B0); PG8_MMA(0, 1, At, B1); PG8_BAR; PG8_SCHED;
            PG8_LDA(At, 0, 1); PG8_STAGE(PG8_SB(0, 0), b2, voffB); PG8_STAGE(PG8_SB(0, 1), b2 + hstepB, voffB); PG8_STAGE(PG8_SA(0, 0), a2, voffA);
            PG8_WAIT_V(8); PG8_WAIT_L(0); PG8_BAR; PG8_MMA(1, 0, At, B0); PG8_MMA(1, 1, At, B1); PG8_BAR; PG8_SCHED;
            PG8_LDB(B0, 1, 0); PG8_LDB(B1, 1, 1); PG8_SCHED; PG8_LDA(At, 1, 0); PG8_STAGE(PG8_SA(0, 1), a2 + hstepA, voffA);
            PG8_WAIT_V(8); PG8_WAIT_L(0); PG8_BAR; PG8_MMA(0, 0, At, B0); PG8_MMA(0, 1, At, B1); PG8_BAR; PG8_SCHED;
            PG8_LDA(At, 1, 1); PG8_STAGE(PG8_SB(1, 0), b3, voffB); PG8_STAGE(PG8_SB(1, 1), b3 + hstepB, voffB); PG8_STAGE(PG8_SA(1, 0), a3, voffA);
            PG8_WAIT_V(8); PG8_WAIT_L(0); PG8_BAR; PG8_MMA(1, 0, At, B0); PG8_MMA(1, 1, At, B1); PG8_BAR; PG8_SCHED;
            } else {
            PG8_LDB(B0, 0, 0); PG8_SCHED; PG8_LDA(At, 0, 0); PG8_STAGE(PG8_SA(1, 1), a1 + hstepA, voffA);
            PG8_WAIT_L(8); PG8_BAR; PG8_WAIT_L(0); PG8_MMA(0, 0, At, B0); PG8_BAR; PG8_SCHED;
            PG8_LDB(B1, 0, 1); PG8_STAGE(PG8_SB(0, 0), b2, voffB);
            PG8_BAR; PG8_WAIT_L(0); PG8_MMA(0, 1, At, B1); PG8_BAR;
            PG8_LDA(At, 0, 1); PG8_STAGE(PG8_SA(0, 0), a2, voffA);
            PG8_BAR; PG8_WAIT_L(0); PG8_MMA(1, 0, At, B0); PG8_BAR; PG8_SCHED;
            PG8_STAGE(PG8_SB(0, 1), b2 + hstepB, voffB);
            PG8_WAIT_V(6); PG8_BAR; PG8_MMA(1, 1, At, B1); PG8_BAR;
            PG8_LDB(B0, 1, 0); PG8_SCHED; PG8_LDA(At, 1, 0); PG8_STAGE(PG8_SA(0, 1), a2 + hstepA, voffA);
            PG8_WAIT_L(8); PG8_BAR; PG8_WAIT_L(0); PG8_MMA(0, 0, At, B0); PG8_BAR; PG8_SCHED;
            PG8_LDB(B1, 1, 1); PG8_STAGE(PG8_SB(1, 0), b3, voffB);
            PG8_BAR; PG8_WAIT_L(0); PG8_MMA(0, 1, At, B1); PG8_BAR;
            PG8_LDA(At, 1, 1); PG8_STAGE(PG8_SA(1, 0), a3, voffA);
            PG8_BAR; PG8_WAIT_L(0); PG8_MMA(1, 0, At, B0); PG8_BAR; PG8_SCHED;
            PG8_STAGE(PG8_SB(1, 1), b3 + hstepB, voffB);
            PG8_WAIT_V(6); PG8_BAR; PG8_MMA(1, 1, At, B1); PG8_BAR;
            }
        }
        if constexpr (ALIGN_EPI) { if (wr == 0) PG8_BAR; }
        if constexpr (!Epi::AFTER_DRAIN) { E(acc, cur, wr, wc, fr, fq); S.done(cur); }
        if (!has_next) break;
#pragma unroll
        for (int a = 0; a < 2; ++a)
#pragma unroll
            for (int b = 0; b < 2; ++b)
#pragma unroll
                for (int m = 0; m < 4; ++m)
#pragma unroll
                    for (int n = 0; n < 2; ++n) acc[a][b][m][n] = (f32x4){0.f, 0.f, 0.f, 0.f};
        cur = nxt; cA = nA; cB = nB; ++ui;
        if constexpr (ALIGN_EPI) { if (wr == 1) PG8_BAR; }
    }
    PG8_WAIT_V(0);
    if constexpr (!ALIGN_EPI) { if (wr == 0) PG8_BAR; }
    PG8_BAR;
    if constexpr (Epi::AFTER_DRAIN) { E.fused(acc, cur, wr, wc, fr, fq, lds, wid, lane); S.done(cur); }
#undef PG8_AOFF
#undef PG8_SA
#undef PG8_SB
#undef PG8_STAGE
#undef PG8_LDA
#undef PG8_LDB
#undef PG8_MMA
#undef PG8_WAIT_V
#undef PG8_WAIT_L
#undef PG8_BAR
#undef PG8_SCHED
}
}
namespace fox {
typedef unsigned short bf16;
typedef short bf16x8 __attribute__((ext_vector_type(8)));
typedef short s16x4 __attribute__((ext_vector_type(4)));
typedef float f32x16 __attribute__((ext_vector_type(16)));
typedef float f32x4 __attribute__((ext_vector_type(4)));
typedef unsigned u32x4 __attribute__((ext_vector_type(4)));
constexpr int D = 128, T = 4096, NH = 16, OLD = 2048;
constexpr int NW = 8, QBLK = 32, KVBLK = 64, QB = NW * QBLK;
constexpr int SHM_V = KVBLK * D * 2, SHM_K = KVBLK * D * 2;
constexpr int LDS_WS = 2 * SHM_V + 2 * SHM_K, LDS_F = LDS_WS + NW * 64 * 4, LDS_BYTES = LDS_F + T * 4;
constexpr float THR = 8.f;
constexpr float LOG2E = 1.4426950408889634f;
constexpr float QSCALE = LOG2E * 0.08838834764831845f;

#define KSWZ(row, colB) ((row) * 256 + ((colB) ^ (((row) & 7) << 4)))
#define SBAR() __builtin_amdgcn_sched_barrier(0)
__device__ __forceinline__ int v_st(int k, int c) { const int kk = (k & ~0xC) | ((k & 4) << 1) | ((k & 8) >> 1); return ((kk >> 3) * 4 + (c >> 5)) * 512 + ((kk & 7) * 32 + (c & 31)) * 2; }
__device__ __forceinline__ int v_rd_base(int lane) { return ((lane & 3) << 3) | (((lane >> 2) & 3) << 6) | (((lane >> 4) & 1) << 5) | (((lane >> 5) & 1) << 8); }
constexpr int v_rd_off(int d0, int ks, int half) { return d0 * 512 + ks * 4096 + half * 2048; }
__device__ __forceinline__ int crow(int r, int hi) { return (r & 3) + 8 * (r >> 2) + 4 * hi; }
__device__ __forceinline__ unsigned cvtpk(float lo, float hi) {
    unsigned r; asm volatile("v_cvt_pk_bf16_f32 %0, %1, %2" : "=v"(r) : "v"(lo), "v"(hi)); return r;
}
__device__ __forceinline__ bf16x8 load8(const bf16* p) { return *reinterpret_cast<const bf16x8*>(p); }
__device__ __forceinline__ void mask_tile(f32x16& p0, f32x16& p1, int dq) {
    const float NEG = -__builtin_inff();
#pragma unroll
    for (int r = 0; r < 16; ++r) {
        const int c = (r & 3) + 8 * (r >> 2);
        if (dq - c < 0) p0[r] = NEG;
        if (dq - c - 32 < 0) p1[r] = NEG;
    }
}
__device__ __forceinline__ void partialSM(f32x16& p0, f32x16& p1, float& m_reg, float& mn, float& alpha) {
    float pmax = p0[0];
#pragma unroll
    for (int r = 1; r < 16; ++r) pmax = fmaxf(pmax, p0[r]);
#pragma unroll
    for (int r = 0; r < 16; ++r) pmax = fmaxf(pmax, p1[r]);
    { auto rr = __builtin_amdgcn_permlane32_swap(__float_as_uint(pmax), __float_as_uint(pmax), false, false);
      pmax = fmaxf(__uint_as_float(rr[0]), __uint_as_float(rr[1])); }
    if (__builtin_expect(__all((pmax - m_reg) <= THR), 1)) { mn = m_reg; alpha = 1.f; }
    else { mn = fmaxf(m_reg, pmax); alpha = __builtin_amdgcn_exp2f(m_reg - mn); m_reg = mn; }
#pragma unroll
    for (int r = 0; r < 16; ++r) p0[r] = p0[r] - mn;
#pragma unroll
    for (int r = 0; r < 16; ++r) p1[r] = p1[r] - mn;
#pragma unroll
    for (int r = 0; r < 16; ++r) p0[r] = __builtin_amdgcn_exp2f(p0[r]);
}
__device__ __forceinline__ void finishSM(f32x16& p0, f32x16& p1, float alpha, float& l_reg, bf16x8& pa0, bf16x8& pa1, bf16x8& pa2, bf16x8& pa3) {
#pragma unroll
    for (int r = 0; r < 16; ++r) p1[r] = __builtin_amdgcn_exp2f(p1[r]);
    float ps = 0;
#pragma unroll
    for (int r = 0; r < 16; ++r) ps += p0[r];
#pragma unroll
    for (int r = 0; r < 16; ++r) ps += p1[r];
    { auto rr = __builtin_amdgcn_permlane32_swap(__float_as_uint(ps), __float_as_uint(ps), false, false);
      ps = __uint_as_float(rr[0]) + __uint_as_float(rr[1]); }
    l_reg = l_reg * alpha + ps;
#define PK4(P, B_, OUT) do { unsigned a0 = cvtpk(P[B_+0], P[B_+1]), a1 = cvtpk(P[B_+2], P[B_+3]);                          \
        unsigned b0 = cvtpk(P[B_+4], P[B_+5]), b1 = cvtpk(P[B_+6], P[B_+7]);                                             \
        auto r0 = __builtin_amdgcn_permlane32_swap(a0, b0, false, false); auto r1 = __builtin_amdgcn_permlane32_swap(a1, b1, false, false); \
        u32x4 w = {r0[0], r1[0], r0[1], r1[1]}; OUT = *reinterpret_cast<bf16x8*>(&w); } while (0)
    PK4(p0, 0, pa0); PK4(p0, 8, pa1); PK4(p1, 0, pa2); PK4(p1, 8, pa3);
#undef PK4
}
template <int KB>
__device__ __forceinline__ void qkt(f32x16& p0, f32x16& p1, const char* K_lds, int r32, int hi, const bf16x8* qr, float fqv, const float* fk) {
#pragma unroll
    for (int g = 0; g < 4; ++g) {
        const f32x4 a = *reinterpret_cast<const f32x4*>(fk + 8 * g), b = *reinterpret_cast<const f32x4*>(fk + 32 + 8 * g);
#pragma unroll
        for (int j = 0; j < 4; ++j) { p0[4 * g + j] = fqv - a[j]; p1[4 * g + j] = fqv - b[j]; }
    }
    const char* kb[4];
#pragma unroll
    for (int dd = 0; dd < 4; ++dd) kb[dd] = K_lds + KB * SHM_K + KSWZ(r32, (dd * 16 + hi * 8) * 2);
#pragma unroll
    for (int d0 = 0; d0 < 8; ++d0) { const char* a = kb[d0 & 3] + (d0 >> 2) * 128;
        bf16x8 b0 = *reinterpret_cast<const bf16x8*>(a);
        bf16x8 b1 = *reinterpret_cast<const bf16x8*>(a + 32 * 256);
        p0 = __builtin_amdgcn_mfma_f32_32x32x16_bf16(b0, qr[d0], p0, 0, 0, 0);
        p1 = __builtin_amdgcn_mfma_f32_32x32x16_bf16(b1, qr[d0], p1, 0, 0, 0); }
}
template <int VB>
__device__ __forceinline__ void pv_tile(f32x16* o, int vb0, bf16x8 pa0, bf16x8 pa1, bf16x8 pa2, bf16x8 pa3) {
#define TRRD(dst, off) asm volatile("ds_read_b64_tr_b16 %0, %1 offset:%2" : "=&v"(dst) : "v"(vb0), "i"(off) : "memory")
#define PV_D0(d0) do { s16x4 l0, l1, l2, l3, h0, h1, h2, h3; constexpr int b_ = VB * SHM_V + v_rd_off(d0, 0, 0);     \
        TRRD(l0, b_); TRRD(h0, b_ + 2048); TRRD(l1, b_ + 4096); TRRD(h1, b_ + 6144); TRRD(l2, b_ + 8192); TRRD(h2, b_ + 10240); TRRD(l3, b_ + 12288); TRRD(h3, b_ + 14336); \
        asm volatile("s_waitcnt lgkmcnt(0)" ::: "memory"); SBAR();                 \
        o[d0] = __builtin_amdgcn_mfma_f32_32x32x16_bf16(pa0, (bf16x8){l0[0], l0[1], l0[2], l0[3], h0[0], h0[1], h0[2], h0[3]}, o[d0], 0, 0, 0);   \
        o[d0] = __builtin_amdgcn_mfma_f32_32x32x16_bf16(pa1, (bf16x8){l1[0], l1[1], l1[2], l1[3], h1[0], h1[1], h1[2], h1[3]}, o[d0], 0, 0, 0);   \
        o[d0] = __builtin_amdgcn_mfma_f32_32x32x16_bf16(pa2, (bf16x8){l2[0], l2[1], l2[2], l2[3], h2[0], h2[1], h2[2], h2[3]}, o[d0], 0, 0, 0);   \
        o[d0] = __builtin_amdgcn_mfma_f32_32x32x16_bf16(pa3, (bf16x8){l3[0], l3[1], l3[2], l3[3], h3[0], h3[1], h3[2], h3[3]}, o[d0], 0, 0, 0); } while (0)
    PV_D0(0); PV_D0(1); PV_D0(2); PV_D0(3);
#undef PV_D0
#undef TRRD
}

struct BlockRef { const bf16* Q; const bf16* K; const bf16* V; bf16* O; int P0; int JLO; };
struct Seam { bf16x8 qr[8]; bf16x8 st_v0, st_v1, st_k0, st_k1; };
#define ROW(p, k0, rr) ((p) + (size_t)((k0) + (rr)) * D + sc)
#define VMW() asm volatile("s_waitcnt vmcnt(0)" ::: "memory")
#define VMWN(n) asm volatile("s_waitcnt vmcnt(%0)" :: "i"(n) : "memory")
#define SLOAD_H(Kp, Vp, k0) do { S.st_v0 = load8(ROW(Vp, k0, sr)); S.st_v1 = load8(ROW(Vp, k0, 32 + sr));              \
                         S.st_k0 = load8(ROW(Kp, k0, sr)); S.st_k1 = load8(ROW(Kp, k0, 32 + sr)); } while (0)
#define SWRITE_HK(bf) do { *(bf16x8*)(K_lds + (bf) * SHM_K + kws) = S.st_k0; *(bf16x8*)(K_lds + (bf) * SHM_K + kws + 32 * 256) = S.st_k1; } while (0)
#define SWRITE_HV(bf) do { *(bf16x8*)(V_lds + (bf) * SHM_V + vst0) = S.st_v0; *(bf16x8*)(V_lds + (bf) * SHM_V + vst1) = S.st_v1; } while (0)
#define SWRITE_H(bf) do { SWRITE_HV(bf); SWRITE_HK(bf); } while (0)
__device__ __forceinline__ void fox_prime(const BlockRef& cur, char* lds, Seam& S) {
    const int tid = opaque_tid(), wid = __builtin_amdgcn_readfirstlane(tid >> 6), lane = tid & 63, r32 = lane & 31, hi = lane >> 5;
    const int sr = tid >> 4, sc = (tid & 15) * 8, kws = KSWZ(sr, sc * 2); char* K_lds = lds + 2 * SHM_V;
    const int kb0 = cur.JLO * KVBLK;
#pragma unroll
    for (int d0 = 0; d0 < 8; ++d0) S.qr[d0] = load8(cur.Q + (size_t)(wid * QBLK + r32) * D + d0 * 16 + hi * 8);
    SLOAD_H(cur.K, cur.V, kb0); VMW(); SWRITE_HK(0);
    __syncthreads();
}
__device__ __forceinline__ void fox_block(const BlockRef& cur, const BlockRef& nxt, char* lds, Seam& S) {
    const int tid = opaque_tid(), wid = __builtin_amdgcn_readfirstlane(tid >> 6), lane = tid & 63, r32 = lane & 31, hi = lane >> 5;
    const int j_lo = cur.JLO;
    const int j_hi = (cur.P0 + QB - 1) / KVBLK + 1;
    const int NT = j_hi - j_lo;
    const int kbn = nxt.JLO * KVBLK;
    const int qlo = cur.P0 + wid * QBLK, qm = qlo + r32 - 4 * hi;
    char* V_lds = lds; char* K_lds = lds + 2 * SHM_V;
    float* ws = (float*)(lds + LDS_WS) + wid * 64; float* li_l = ws, * al_l = ws + 32;
    const float* Fl = (const float*)(lds + LDS_F);
    const float fqv = Fl[qlo + r32];
    float m_reg = -1e30f, l_reg = 0; f32x16 o[4] = {};
    const int sr = tid >> 4, sc = (tid & 15) * 8, vst0 = v_st(sr, sc), vst1 = v_st(32 + sr, sc), kws = KSWZ(sr, sc * 2);
    const int vb0 = (int)(uintptr_t)V_lds + v_rd_base(lane);
    const bf16* Kh = cur.K; const bf16* Vh = cur.V;
#define RESC(a) do { if (__any((a) < 1.f)) { if (hi == 0) al_l[r32] = (a); asm volatile("s_waitcnt lgkmcnt(0)" ::: "memory");              \
                     for (int d_ = 0; d_ < 4; ++d_) for (int r = 0; r < 16; ++r) o[d_][r] *= al_l[crow(r, hi)]; } } while (0)
#define KBASE(t) ((j_lo + (t)) * KVBLK)
#define FK(t) (Fl + KBASE(t) + 4 * hi)
#define MASKT(P0_, P1_, t) do { const int kb_ = KBASE(t); if (kb_ + KVBLK - 1 > qlo) mask_tile(P0_, P1_, qm - kb_); } while (0)
    constexpr int NQL = 8;
#define SEAM_K0() do { VMWN(NQL); SWRITE_HK(0); SBAR(); } while (0)
    f32x16 pA0, pA1, pB0, pB1; float mnA, mnB, alA, alB; bf16x8 pa0, pa1, pa2, pa3;
    SWRITE_HV(0); SBAR();
    if (NT > 1) SLOAD_H(Kh, Vh, KBASE(1));
    SBAR(); qkt<0>(pA0, pA1, K_lds, r32, hi, S.qr, fqv, FK(0));
    MASKT(pA0, pA1, 0); partialSM(pA0, pA1, m_reg, mnA, alA);
    if (NT > 1) { VMW(); SWRITE_H(1); }
    __syncthreads();
#define HALF_STEP(PX0, PX1, mnX, alX, PY0, PY1, alY, t, KB, VB, SB) do {                                                      \
        SBAR(); qkt<KB>(PX0, PX1, K_lds, r32, hi, S.qr, fqv, FK(t));                                                          \
        finishSM(PY0, PY1, alY, l_reg, pa0, pa1, pa2, pa3); SBAR();                                                           \
        if ((t) + 1 < NT) { SLOAD_H(Kh, Vh, KBASE((t) + 1)); SBAR(); }                                                        \
        pv_tile<VB>(o, vb0, pa0, pa1, pa2, pa3); MASKT(PX0, PX1, (t)); partialSM(PX0, PX1, m_reg, mnX, alX);                  \
        __syncthreads();                                                                                                      \
        if ((t) + 1 < NT) { VMW(); SWRITE_H(SB); }                                                                            \
        RESC(alX); __syncthreads(); } while (0)
    for (int t = 1; t + 1 < NT; t += 2) {
        HALF_STEP(pB0, pB1, mnB, alB, pA0, pA1, alA, t, 1, 0, 0);
        HALF_STEP(pA0, pA1, mnA, alA, pB0, pB1, alB, t + 1, 0, 1, 1);
    }
    const bool even = (NT & 1) == 0;
    if (even) { SBAR(); qkt<1>(pB0, pB1, K_lds, r32, hi, S.qr, fqv, FK(NT - 1)); SBAR(); }
    SLOAD_H(nxt.K, nxt.V, kbn); SBAR();
#pragma unroll
    for (int d0 = 0; d0 < 8; ++d0) S.qr[d0] = load8(nxt.Q + (size_t)(wid * QBLK + r32) * D + d0 * 16 + hi * 8);
    SBAR();
    finishSM(pA0, pA1, alA, l_reg, pa0, pa1, pa2, pa3); SBAR();
    pv_tile<0>(o, vb0, pa0, pa1, pa2, pa3);
    if (even) { MASKT(pB0, pB1, NT - 1); partialSM(pB0, pB1, m_reg, mnB, alB); __syncthreads(); RESC(alB);
        finishSM(pB0, pB1, alB, l_reg, pa0, pa1, pa2, pa3); SBAR(); pv_tile<1>(o, vb0, pa0, pa1, pa2, pa3); }
    SBAR(); SEAM_K0();
    if (hi == 0) li_l[r32] = l_reg; asm volatile("s_waitcnt lgkmcnt(0)" ::: "memory");
    float rli[16];
#pragma unroll
    for (int r = 0; r < 16; ++r) rli[r] = __builtin_amdgcn_rcpf(li_l[crow(r, hi)]);
    bf16* Ow = cur.O + (size_t)(wid * QBLK) * OLD;
#pragma unroll
    for (int r = 0; r < 16; ++r) { const int orow = crow(r, hi);
#pragma unroll
        for (int d0 = 0; d0 < 4; ++d0) { const float v = o[d0][r] * rli[r];
            const float vn = __shfl_xor(v, 1);
            if ((r32 & 1) == 0) *(unsigned*)(Ow + (size_t)orow * OLD + d0 * 32 + r32) = cvtpk(v, vn); } }
    __syncthreads();
#undef RESC
#undef KBASE
#undef FK
#undef MASKT
#undef SEAM_K0
#undef HALF_STEP
}
#undef ROW
#undef VMW
#undef VMWN
#undef SLOAD_H
#undef SWRITE_HK
#undef SWRITE_HV
#undef SWRITE_H
#undef SBAR
#undef KSWZ
}

#define GAS __attribute__((address_space(1)))
#define LAS __attribute__((address_space(3)))
typedef unsigned short bf16;
typedef unsigned v4u __attribute__((ext_vector_type(4)));
typedef float f32x4 __attribute__((ext_vector_type(4)));
typedef short bf16x8 __attribute__((ext_vector_type(8)));
typedef GAS unsigned gu32;
typedef GAS unsigned long long gu64;
#define RLX_AGENT __ATOMIC_RELAXED, __HIP_MEMORY_SCOPE_AGENT
#define LDS_WAIT() asm volatile("s_waitcnt lgkmcnt(0)" ::: "memory")
#define VM_WAIT() asm volatile("s_waitcnt vmcnt(0)" ::: "memory")
__device__ __forceinline__ unsigned long long rt() { return __builtin_amdgcn_s_memrealtime(); }
__device__ __forceinline__ unsigned f2bf(float f) { unsigned u = __builtin_bit_cast(unsigned, f); return (u + 0x7fffu + ((u >> 16) & 1u)) >> 16; }
__device__ __forceinline__ unsigned pk2(float lo, float hi) { return f2bf(lo) | (f2bf(hi) << 16); }

#define XB_TMO      128
#define XB_XCNT(j)  (256  + 64 * (j))
#define XB_XSUB(j)  (1280 + 64 * (j))
#define XB_XGEN(j)  (2304 + 64 * (j))
#define XB_TOP      3328
#define XB_TOPGEN   3392
#define XCD_BAR_WORDS 3456
#define XB_SPIN_CAP (1u << 21)

__device__ __forceinline__ unsigned xb_ld(unsigned* p)              { return __hip_atomic_load(p, __ATOMIC_RELAXED, __HIP_MEMORY_SCOPE_AGENT); }
__device__ __forceinline__ unsigned xb_add(unsigned* p, unsigned v) { return __hip_atomic_fetch_add(p, v, __ATOMIC_RELAXED, __HIP_MEMORY_SCOPE_AGENT); }
__device__ __forceinline__ unsigned xb_xcc_id() { return (unsigned)__builtin_amdgcn_s_getreg((3 << 11) | 20) & 0xFu; }
#define XB_SPIN(cond, bar) do { unsigned _sp = 0; while (cond) { __builtin_amdgcn_s_sleep(1); \
    if ((++_sp & 255u) == 0u) { if (xb_ld(&(bar)[XB_TMO])) break; if (_sp > XB_SPIN_CAP) { atomicAdd(&(bar)[XB_TMO], 1u); break; } } } } while (0)

struct XcdBarrier {
    unsigned* bar; unsigned x;
    volatile LAS unsigned* st;
};

__device__ __forceinline__ XcdBarrier xcd_barrier_post(unsigned* bar, volatile LAS unsigned* st) {
    XcdBarrier b; b.bar = bar; b.x = xb_xcc_id(); b.st = st;
    if (threadIdx.x == 0) (void)xb_add(&bar[XB_XCNT(b.x)], 1u);
    return b;
}
__device__ __forceinline__ void xcd_barrier_complete(unsigned* bar, unsigned x, unsigned& nloc, unsigned& nx) {
    const unsigned G = gridDim.x * gridDim.y * gridDim.z;
    unsigned sum, cnt, mine, sp = 0u;
    for (;;) {
        sum = 0u; cnt = 0u; mine = 0u;
#pragma unroll
        for (unsigned j = 0; j < 16; ++j) { const unsigned c = xb_ld(&bar[XB_XCNT(j)]); sum += c; cnt += (c > 0u) ? 1u : 0u; mine = (j == x) ? c : mine; }
        if (sum == G) break;
        __builtin_amdgcn_s_sleep(1);
        if ((++sp & 255u) == 0u) { if (xb_ld(&bar[XB_TMO])) break; if (sp > XB_SPIN_CAP) { atomicAdd(&bar[XB_TMO], 1u); break; } }
    }
    nloc = mine > 0u ? mine : 1u; nx = cnt > 0u ? cnt : 1u;
}

__device__ __forceinline__ void xcd_barrier(const XcdBarrier& b) {
    asm volatile("s_waitcnt vmcnt(0)" ::: "memory");
    __syncthreads();
    if (threadIdx.x == 0) {
        unsigned* bar = b.bar;
        __builtin_amdgcn_s_waitcnt(0);
        unsigned nloc = b.st[0], nx = b.st[1];
        if (nloc == 0u) { xcd_barrier_complete(bar, b.x, nloc, nx); b.st[0] = nloc; b.st[1] = nx; }
        const unsigned old = xb_add(&bar[XB_XSUB(b.x)], 1u);
        const unsigned gen = old / nloc;
        if (old + 1u == (gen + 1u) * nloc) {
            __builtin_amdgcn_fence(__ATOMIC_RELEASE, "agent");
            asm volatile("s_waitcnt vmcnt(0)" ::: "memory");
            const unsigned og = xb_add(&bar[XB_TOP], 1u);
            const unsigned tg = og / nx;
            if (og + 1u == (tg + 1u) * nx) xb_add(&bar[XB_TOPGEN], 1u);
            else XB_SPIN(xb_ld(&bar[XB_TOPGEN]) == tg, bar);
            __builtin_amdgcn_fence(__ATOMIC_ACQUIRE, "agent");
            xb_add(&bar[XB_XGEN(b.x)], 1u);
            asm volatile("s_waitcnt vmcnt(0)" ::: "memory");
        } else {
            XB_SPIN(xb_ld(&bar[XB_XGEN(b.x)]) == gen, bar);
            __builtin_amdgcn_fence(__ATOMIC_ACQUIRE, "agent");
            asm volatile("s_waitcnt vmcnt(0)" ::: "memory");
        }
    }
    __syncthreads();
}

constexpr int NWAVES = 8;
constexpr int BATCH = 2, SEQ = 4096, DMODEL = 2048, DFF = 5632, DEPTH = 4, NHEAD = 16, HDIM = 128;
constexpr int M = BATCH * SEQ;
constexpr int NGU = 2 * DFF;
constexpr int NQKV = 3 * DMODEL;
constexpr int WIN_LD = 3 * DMODEL + NHEAD;
#ifndef MK_MULTI
#define MK_MULTI 0
#endif
constexpr int N_PHASES = 1 + 16 + 4 + 8;

constexpr size_t MiB = 1u << 20;
constexpr size_t WS_CTL = 0, CTL_ZERO_BYTES = 1 * MiB;
constexpr size_t SZ_WGU = (size_t)NGU * DMODEL * 2, SZ_WD = (size_t)DMODEL * DFF * 2;
constexpr size_t SZ_WFIN = (size_t)NQKV * DMODEL * 2, SZ_WFOUT = (size_t)DMODEL * DMODEL * 2, SZ_WPOOL = (size_t)DMODEL * 512 * 2;
constexpr size_t WS_WGU = 1 * MiB;
constexpr size_t WS_WD = WS_WGU + 8 * SZ_WGU;
constexpr size_t WS_WFIN = WS_WD + 8 * SZ_WD;
constexpr size_t WS_WFOUT = WS_WFIN + 2 * SZ_WFIN;
constexpr size_t WS_WPOOL = WS_WFOUT + 2 * SZ_WFOUT;
constexpr size_t WS_WFT = WS_WPOOL + 2 * SZ_WPOOL;
constexpr size_t WS_SSQ = WS_WFT + 2 * 16 * 2048 * 4;
constexpr size_t WS_LF = WS_SSQ + (size_t)M * 32 * 4;
constexpr size_t WS_XG = WS_LF + (size_t)32 * 4096 * 4;
constexpr size_t WS_HACT = WS_XG + (size_t)M * DMODEL * 2;
constexpr size_t WS_Q = WS_HACT + (size_t)M * DFF * 2;
constexpr size_t WS_K = WS_Q + (size_t)M * DMODEL * 2;
constexpr size_t WS_V = WS_K + (size_t)M * DMODEL * 2;
constexpr size_t WS_O = WS_V + (size_t)M * DMODEL * 2;
constexpr size_t WS_END = WS_O + (size_t)M * DMODEL * 2;
static_assert(WS_WGU % 256 == 0 && WS_WD % 256 == 0 && WS_WFIN % 256 == 0 && WS_XG % 256 == 0 && WS_HACT % 256 == 0 && WS_Q % 256 == 0 && WS_O % 256 == 0, "alignment");
constexpr int CW_BAR = 4096;

constexpr int RING_OFF = 0, RING_BYTES = 131072;
constexpr int LDSCTL_OFF = RING_BYTES, MISC_OFF = LDSCTL_OFF + 320;
constexpr int LDS_BYTES = 147456;
static_assert(MISC_OFF + 128 <= LDS_BYTES && fox::LDS_BYTES <= RING_BYTES, "LDS map");


struct Args { const float* in[17]; float* out; unsigned char* ws; int ph_lo, ph_hi; };
struct Frame {
    LAS unsigned char* lds;
    volatile LAS unsigned* MISC;
    gu32* ctl;
    int tid, lane, wave, vcu, G;
};
typedef unsigned long long u64_t;
__device__ __forceinline__ float wave_sum(float v) {
#pragma unroll
    for (int o = 1; o < 64; o <<= 1) v += __shfl_xor(v, o);
    return v;
}
__device__ __forceinline__ float bf2f(unsigned short u) { return __builtin_bit_cast(float, (unsigned)u << 16); }

__device__ __forceinline__ void transpose_item(const float* W, int ldw, bf16* WT, int kd, LAS float* scr, int lane) {
#pragma unroll 8
    for (int i = 0; i < 32; ++i) { const int kk = 2 * i + (lane >> 5); scr[kk * 33 + (lane & 31)] = W[(size_t)kk * ldw + (lane & 31)]; }
    LDS_WAIT(); asm volatile("" ::: "memory");
    const int c = lane & 7;
#pragma unroll
    for (int j = 0; j < 4; ++j) { const int n = (lane >> 3) + 8 * j; const LAS float* s = scr + (8 * c) * 33 + n;
        v4u o; o.x = pk2(s[0 * 33], s[1 * 33]); o.y = pk2(s[2 * 33], s[3 * 33]); o.z = pk2(s[4 * 33], s[5 * 33]); o.w = pk2(s[6 * 33], s[7 * 33]);
        *(GAS v4u*)(WT + (size_t)n * kd + 8 * c) = o; }
    LDS_WAIT(); asm volatile("" ::: "memory");
}
__device__ __forceinline__ void p_prologue(const Args& a, Frame& F) {
    const int lane = opaque_tid() & 63;
    LAS float* scr = (LAS float*)(F.lds + RING_OFF + F.wave * 16384);
    const int gw = F.vcu * NWAVES + F.wave, NGW = F.G * NWAVES;
    unsigned char* ws = a.ws;
    constexpr int I_FFN = 8 * 3 * 5632, I_FIN = 2 * 6144, I_FOUT = 2 * 2048, I_POOL = 8 * 128, NITEMS = I_FFN + I_FIN + I_FOUT + I_POOL;
    for (int it = gw; it < NITEMS; it += NGW) {
        int r = it; const float* src; int ldw; bf16* dst; int kd;
        if (r < I_FFN) {
            const int s = r / 16896, q = r % 16896, mat = q / 5632, i = q % 5632, L = s >> 1, f = s & 1;
            if (mat < 2) {
                const int kb = i / 176, nb = i % 176, n0 = 32 * nb;
                const float* Wm = (mat == 0 ? (f ? a.in[14] : a.in[2]) : (f ? a.in[15] : a.in[3])) + (size_t)L * DMODEL * DFF;
                src = Wm + (size_t)(64 * kb) * DFF + n0; ldw = DFF;
                const int drow = (n0 >> 7) * 256 + (n0 & 127) + mat * 128;
                dst = (bf16*)(ws + WS_WGU + (size_t)s * SZ_WGU) + (size_t)drow * DMODEL + 64 * kb; kd = DMODEL;
            } else {
                const int kb = i / 64, nb = i % 64, n0 = 32 * nb;
                const float* Wm = (f ? a.in[16] : a.in[4]) + (size_t)L * DFF * DMODEL;
                src = Wm + (size_t)(64 * kb) * DMODEL + n0; ldw = DMODEL;
                dst = (bf16*)(ws + WS_WD + (size_t)s * SZ_WD) + (size_t)n0 * DFF + 64 * kb; kd = DFF;
            }
        } else if ((r -= I_FFN) < I_FIN) {
            const int j = r / 6144, i = r % 6144, kb = i / 192, nb = i % 192, n0 = 32 * nb;
            src = a.in[8] + (size_t)j * DMODEL * WIN_LD + (size_t)(64 * kb) * WIN_LD + n0; ldw = WIN_LD;
            dst = (bf16*)(ws + WS_WFIN + (size_t)j * SZ_WFIN) + (size_t)n0 * DMODEL + 64 * kb; kd = DMODEL;
        } else if ((r -= I_FIN) < I_FOUT) {
            const int j = r / 2048, i = r % 2048, kb = i / 64, nb = i % 64, n0 = 32 * nb;
            src = a.in[12] + (size_t)j * DMODEL * DMODEL + (size_t)(64 * kb) * DMODEL + n0; ldw = DMODEL;
            dst = (bf16*)(ws + WS_WFOUT + (size_t)j * SZ_WFOUT) + (size_t)n0 * DMODEL + 64 * kb; kd = DMODEL;
        } else {
            r -= I_FOUT;
            const int jg = r / 128, i = r % 128, kb = i / 16, nb = i % 16, n0 = 32 * nb;
            src = a.in[6] + (size_t)jg * 512 * 512 + (size_t)(64 * kb) * 512 + n0; ldw = 512;
            dst = (bf16*)(ws + WS_WPOOL) + (size_t)jg * 512 * 512 + (size_t)n0 * 512 + 64 * kb; kd = 512;
        }
        transpose_item(src, ldw, dst, kd, scr, lane);
    }
    {
        float* wft = (float*)(ws + WS_WFT);
        for (int idx = gw * 64 + lane; idx < 2 * 16 * 2048; idx += NGW * 64) {
            const int j = idx >> 15, h = (idx >> 11) & 15, k = idx & 2047;
            wft[idx] = a.in[8][((size_t)j * DMODEL + k) * WIN_LD + NQKV + h];
        }
    }
    {
        bf16* XG = (bf16*)(ws + WS_XG); float* SSQ = (float*)(ws + WS_SSQ);
        for (int m = gw; m < M; m += NGW) {
            const GAS f32x4* xr = (const GAS f32x4*)(a.in[0] + (size_t)m * DMODEL) + lane;
            const GAS f32x4* gr = (const GAS f32x4*)(a.in[1]) + lane;
            f32x4 v[8]; float s = 0.f;
#pragma unroll
            for (int j = 0; j < 8; ++j) { v[j] = xr[64 * j]; s += (v[j].x * v[j].x + v[j].y * v[j].y) + (v[j].z * v[j].z + v[j].w * v[j].w); }
            s = wave_sum(s);
            GAS u64_t* o8 = (GAS u64_t*)(XG + (size_t)m * DMODEL) + lane;
#pragma unroll
            for (int j = 0; j < 8; ++j) { const f32x4 t = v[j] * gr[64 * j]; o8[64 * j] = (u64_t)pk2(t.x, t.y) | ((u64_t)pk2(t.z, t.w) << 32); }
            if (lane < 32) SSQ[(size_t)m * 32 + lane] = lane == 0 ? s : 0.f;
        }
    }
}

__device__ __forceinline__ void p_diff(const Args& a, Frame& F) {
    const bf16* XG = (const bf16*)(a.ws + WS_XG); const float* ssq = (const float*)(a.ws + WS_SSQ); bf16* DIFF = (bf16*)(a.ws + WS_O);
    const int tid = opaque_tid();
    LAS float* rs = (LAS float*)(F.lds + RING_OFF);
    for (int v = F.vcu; v < M / 32; v += F.G) {
        const int r0 = 32 * v, bs = r0 & ~(SEQ - 1);
        if (tid < 48) {
            const int row = r0 - 16 + tid; float val = 0.f;
            if (row >= bs) { const f32x4* p = (const f32x4*)(ssq + (size_t)row * 32); float s = 0.f;
#pragma unroll
                for (int i = 0; i < 8; ++i) { const f32x4 q = p[i]; s += (q.x + q.y) + (q.z + q.w); }
                val = 1.0f / sqrtf(s * (1.0f / DMODEL) + 1e-6f); }
            rs[tid] = val;
        }
        __syncthreads();
        const int ch = tid & 255, half = tid >> 8, g = ch >> 6, w = 2 << g;
        const int tb = r0 + 16 * half;
        const bf16* colp = XG + ch * 8;
        float s[8];
#pragma unroll
        for (int i = 0; i < 8; ++i) s[i] = 0.f;
#define H8(row, dst) do { const bf16x8 raw_ = *(const bf16x8*)(colp + (size_t)(row) * DMODEL); const float sc_ = rs[(row) - (r0 - 16)]; \
        _Pragma("unroll") for (int i_ = 0; i_ < 8; ++i_) dst[i_] = bf2f((unsigned short)raw_[i_]) * sc_; } while (0)
        for (int k = 1; k < w; ++k) { const int r = tb - k; if (r >= bs) { float h[8]; H8(r, h);
#pragma unroll
            for (int i = 0; i < 8; ++i) s[i] += h[i]; } }
        for (int i = 0; i < 16; ++i) {
            const int t = tb + i; float h[8]; H8(t, h);
#pragma unroll
            for (int e = 0; e < 8; ++e) s[e] += h[e];
            const int n = t - bs + 1; const float inv = 1.0f / (float)(n < w ? n : w);
            v4u o; o.x = pk2(s[0] * inv - h[0], s[1] * inv - h[1]); o.y = pk2(s[2] * inv - h[2], s[3] * inv - h[3]);
            o.z = pk2(s[4] * inv - h[4], s[5] * inv - h[5]); o.w = pk2(s[6] * inv - h[6], s[7] * inv - h[7]);
            *(GAS v4u*)(DIFF + (size_t)t * DMODEL + ch * 8) = o;
            const int ro = t - w + 1;
            if (ro >= bs) { float h2[8]; H8(ro, h2);
#pragma unroll
                for (int e = 0; e < 8; ++e) s[e] -= h2[e]; }
        }
#undef H8
        __syncthreads();
    }
}

__device__ __forceinline__ void p_qkn(const Args& a, Frame& F, int j) {
    const int lane = opaque_tid() & 63;
    if (F.wave < 2) {
        const float* x = a.out; const float* gmix = a.in[5] + (size_t)(2 * j + 1) * DMODEL; const float* wft = (const float*)(a.ws + WS_WFT) + (size_t)j * 16 * 2048;
        const float* ssq = (const float*)(a.ws + WS_SSQ); const float* bfv = a.in[9] + j * 16; float* LF = (float*)(a.ws + WS_LF);
        const int rl = lane & 15, kq = lane >> 4;
        for (int blk = F.vcu * 2 + F.wave; blk < M / 16; blk += F.G * 2) {
            const int r0 = blk * 16;
            const float* xrow = x + (size_t)(r0 + rl) * DMODEL + 4 * kq; const float* grow = gmix + 4 * kq; const float* wrow = wft + (size_t)rl * DMODEL + 4 * kq;
            f32x4 acc = {0.f, 0.f, 0.f, 0.f};
#pragma unroll 4
            for (int kb = 0; kb < 128; ++kb) {
                const f32x4 xv = *(const f32x4*)(xrow + 16 * kb) * *(const f32x4*)(grow + 16 * kb);
                const f32x4 wv = *(const f32x4*)(wrow + 16 * kb);
                acc = __builtin_amdgcn_mfma_f32_16x16x4f32(xv[0], wv[0], acc, 0, 0, 0);
                acc = __builtin_amdgcn_mfma_f32_16x16x4f32(xv[1], wv[1], acc, 0, 0, 0);
                acc = __builtin_amdgcn_mfma_f32_16x16x4f32(xv[2], wv[2], acc, 0, 0, 0);
                acc = __builtin_amdgcn_mfma_f32_16x16x4f32(xv[3], wv[3], acc, 0, 0, 0);
            }
            const float rs = pg8::row_rstd(ssq, r0 + rl, kq);
            const float bias = bfv[rl];
#pragma unroll
            for (int i = 0; i < 4; ++i) {
                const int ri = kq * 4 + i; const float rsi = __shfl(rs, ri);
                const float fl = acc[i] * rsi + bias;
                const float lf = fminf(fl, 0.f) - log1pf(expf(-fabsf(fl)));
                const int row = r0 + ri, b = row >> 12, t = row & (SEQ - 1);
                LF[((size_t)(b * NHEAD + rl)) * SEQ + t] = lf;
            }
        }
    } else {
        bf16* Qb = (bf16*)(a.ws + WS_Q); bf16* Kb = (bf16*)(a.ws + WS_K);
        const int nw = F.G * 6, wv = F.vcu * 6 + (F.wave - 2), c8 = (lane & 15) * 8;
        float gq[8], gk[8];
#pragma unroll
        for (int i = 0; i < 8; ++i) { gq[i] = a.in[10][j * HDIM + c8 + i] * fox::QSCALE; gk[i] = a.in[11][j * HDIM + c8 + i]; }
        constexpr int NROWS = 32 * SEQ;
        for (int blk = wv; blk < 2 * NROWS / 4; blk += nw) {
            const int row = blk * 4 + (lane >> 4); const bool isk = row >= NROWS;
            bf16* p = (isk ? Kb : Qb) + (size_t)(row & (NROWS - 1)) * HDIM + c8;
            const bf16x8 raw = *(const bf16x8*)p; float f[8]; float ss = 0.f;
#pragma unroll
            for (int i = 0; i < 8; ++i) { f[i] = bf2f((unsigned short)raw[i]); ss += f[i] * f[i]; }
            ss += __shfl_xor(ss, 1); ss += __shfl_xor(ss, 2); ss += __shfl_xor(ss, 4); ss += __shfl_xor(ss, 8);
            const float r = 1.0f / sqrtf(ss * (1.0f / HDIM) + 1e-6f);
            v4u o;
            if (isk) { o.x = pk2(f[0] * r * gk[0], f[1] * r * gk[1]); o.y = pk2(f[2] * r * gk[2], f[3] * r * gk[3]); o.z = pk2(f[4] * r * gk[4], f[5] * r * gk[5]); o.w = pk2(f[6] * r * gk[6], f[7] * r * gk[7]); }
            else     { o.x = pk2(f[0] * r * gq[0], f[1] * r * gq[1]); o.y = pk2(f[2] * r * gq[2], f[3] * r * gq[3]); o.z = pk2(f[4] * r * gq[4], f[5] * r * gq[5]); o.w = pk2(f[6] * r * gq[6], f[7] * r * gq[7]); }
            *(GAS v4u*)p = o;
        }
    }
}

__device__ __forceinline__ void p_attn(const Args& a, Frame& F, char* lds) {
    const fox::bf16* Qb = (const fox::bf16*)(a.ws + WS_Q); const fox::bf16* Kb = (const fox::bf16*)(a.ws + WS_K); const fox::bf16* Vb = (const fox::bf16*)(a.ws + WS_V);
    fox::bf16* Ob = (fox::bf16*)(a.ws + WS_O); const float* LF = (const float*)(a.ws + WS_LF);
    const int it = F.vcu, ltid = opaque_tid(), llane = ltid & 63;
    if (it < 256) {
        const int bh = it >> 3, s = it & 7, b = bh >> 4, h = bh & 15;
        {
            const f32x4* lf = (const f32x4*)(LF + (size_t)bh * SEQ) + 2 * ltid; const f32x4 x0 = lf[0], x1 = lf[1];
            float c[8]; c[0] = x0.x; c[1] = c[0] + x0.y; c[2] = c[1] + x0.z; c[3] = c[2] + x0.w; c[4] = c[3] + x1.x; c[5] = c[4] + x1.y; c[6] = c[5] + x1.z; c[7] = c[6] + x1.w;
            float inc = c[7];
#pragma unroll
            for (int o = 1; o < 64; o <<= 1) { const float n = __shfl_up(inc, o); if (llane >= o) inc += n; }
            float* wsum = (float*)(lds + fox::LDS_WS);
            if (llane == 63) wsum[F.wave] = inc;
            __syncthreads();
            float off = inc - c[7];
            for (int w = 0; w < F.wave; ++w) off += wsum[w];
            float* Fl = (float*)(lds + fox::LDS_F) + 8 * ltid;
            *(f32x4*)Fl = (f32x4){(off + c[0]) * fox::LOG2E, (off + c[1]) * fox::LOG2E, (off + c[2]) * fox::LOG2E, (off + c[3]) * fox::LOG2E};
            *(f32x4*)(Fl + 4) = (f32x4){(off + c[4]) * fox::LOG2E, (off + c[5]) * fox::LOG2E, (off + c[6]) * fox::LOG2E, (off + c[7]) * fox::LOG2E};
            __syncthreads();
        }
#define FOX_REF(qb) fox::BlockRef{Qb + ((size_t)bh * SEQ + (size_t)(qb) * fox::QB) * HDIM, Kb + (size_t)bh * SEQ * HDIM, Vb + (size_t)bh * SEQ * HDIM, \
                                  Ob + ((size_t)b * SEQ + (size_t)(qb) * fox::QB) * DMODEL + h * HDIM, (qb) * fox::QB, 0}
        fox::BlockRef cur = FOX_REF(s);
        fox::Seam S;
        fox::fox_prime(cur, lds, S);
        for (int pass = 0; pass < 2; ++pass) {
            const fox::BlockRef nxt = (pass == 0) ? FOX_REF(15 - s) : cur;
            fox::fox_block(cur, nxt, lds, S);
            cur = nxt;
        }
#undef FOX_REF
    }
}

__global__ void __launch_bounds__(NWAVES * 64, 2) mega_fwd(Args args) {
    extern __shared__ __attribute__((aligned(16))) unsigned char lds[];
    Frame F;
    F.lds = (LAS unsigned char*)lds;
    F.MISC = (volatile LAS unsigned*)(F.lds + MISC_OFF);
    F.tid = threadIdx.x; F.lane = F.tid & 63; F.wave = __builtin_amdgcn_readfirstlane(F.tid >> 6);
    F.G = gridDim.x; { const int bx = blockIdx.x; F.vcu = (F.G % 8 == 0) ? (bx % 8) * (F.G / 8) + bx / 8 : bx; }
    unsigned char* ws = args.ws;
    F.ctl = (gu32*)(ws + WS_CTL);
    for (int u = F.tid; u < (LDS_BYTES - LDSCTL_OFF) / 4; u += NWAVES * 64) ((LAS unsigned*)(F.lds + LDSCTL_OFF))[u] = 0u;
    __syncthreads();
    XcdBarrier bar; bar.bar = (unsigned*)(F.ctl + CW_BAR); bar.x = 0; bar.st = nullptr;
    if (!MK_MULTI) bar = xcd_barrier_post((unsigned*)(F.ctl + CW_BAR), F.MISC + 8);

    const int lo = args.ph_lo, hi = args.ph_hi; int pc = 0;
#define PH_BEGIN if (pc >= lo && pc < hi) {
#define PH_END   if (pc + 1 < hi) xcd_barrier(bar); } ++pc;
    bf16* const XG = (bf16*)(ws + WS_XG); bf16* const HACT = (bf16*)(ws + WS_HACT); float* const SSQ = (float*)(ws + WS_SSQ);

    PH_BEGIN p_prologue(args, F); PH_END

    for (int s = 0; s < 8; ++s) {
        const int L = s >> 1, f = s & 1;
        PH_BEGIN
            pg8::Gemm g{XG, (const bf16*)(ws + WS_WGU + (size_t)s * SZ_WGU), M, NGU, DMODEL, DMODEL, 30, 0};
            pg8::StaticOrder S; S.init(M, NGU, F.G, (int)blockIdx.x);
            pg8::EpiSwiglu E{HACT, DFF, SSQ};
            pg8::gemm_phase<pg8::EpiSwiglu, pg8::StaticOrder, true, true>(F.lds + RING_OFF, g, S, E);
        PH_END
        PH_BEGIN
            const float* gain = (f == 0) ? args.in[5] + (size_t)L * DMODEL : (L < DEPTH - 1 ? args.in[1] + (size_t)(L + 1) * DMODEL : nullptr);
            pg8::Gemm g{HACT, (const bf16*)(ws + WS_WD + (size_t)s * SZ_WD), M, DMODEL, DFF, DFF, 30, 0};
            pg8::StaticOrder S; S.init(M, DMODEL, F.G, (int)blockIdx.x);
            pg8::EpiResid<true> E{s == 0 ? args.in[0] : (const float*)args.out, args.out, nullptr, gain, XG, SSQ};
            pg8::gemm_phase<pg8::EpiResid<true>, pg8::StaticOrder, false, true>(F.lds + RING_OFF, g, S, E);
        PH_END
        if (f == 0) {
            const int j = L >> 1;
            if ((L & 1) == 0) {
                PH_BEGIN p_diff(args, F); PH_END
                PH_BEGIN
                    pg8::Gemm g{(const bf16*)(ws + WS_O), (const bf16*)(ws + WS_WPOOL + (size_t)j * SZ_WPOOL), M, DMODEL, 512, DMODEL, 1, 1024};
                    pg8::StaticOrder S; S.init(M, DMODEL, F.G, (int)blockIdx.x);
                    pg8::EpiResid<false> E{args.out, args.out, args.in[7] + (size_t)j * DMODEL, args.in[13] + (size_t)L * DMODEL, XG, SSQ};
                    pg8::gemm_phase<pg8::EpiResid<false>, pg8::StaticOrder, false, true>(F.lds + RING_OFF, g, S, E);
                PH_END
            } else {
                PH_BEGIN
                    pg8::Gemm g{XG, (const bf16*)(ws + WS_WFIN + (size_t)j * SZ_WFIN), M, NQKV, DMODEL, DMODEL, 30, 0};
                    pg8::StaticOrder S; S.init(M, NQKV, F.G, (int)blockIdx.x);
                    pg8::EpiQKV E{(bf16*)(ws + WS_Q), (size_t)M * DMODEL, SSQ};
                    pg8::gemm_phase<pg8::EpiQKV, pg8::StaticOrder, true, true>(F.lds + RING_OFF, g, S, E);
                PH_END
                PH_BEGIN p_qkn(args, F, j); PH_END
                PH_BEGIN p_attn(args, F, (char*)lds + RING_OFF); PH_END
                PH_BEGIN
                    pg8::Gemm g{(const bf16*)(ws + WS_O), (const bf16*)(ws + WS_WFOUT + (size_t)j * SZ_WFOUT), M, DMODEL, DMODEL, DMODEL, 30, 0};
                    pg8::StaticOrder S; S.init(M, DMODEL, F.G, (int)blockIdx.x);
                    pg8::EpiResid<false> E{args.out, args.out, nullptr, args.in[13] + (size_t)L * DMODEL, XG, SSQ};
                    pg8::gemm_phase<pg8::EpiResid<false>, pg8::StaticOrder, false, true>(F.lds + RING_OFF, g, S, E);
                PH_END
            }
        }
    }
#undef PH_BEGIN
#undef PH_END
}

extern "C" void kernel_launch(void* const* d_in, const int* in_sizes, int n_in, void* d_out, int out_size, void* d_ws, size_t ws_size, hipStream_t stream) {
    static int grid = 0;
    if (grid == 0) {
        if (n_in != 17 || in_sizes[0] != M * DMODEL || out_size != M * DMODEL || ws_size < WS_END) {
            fprintf(stderr, "kernel_launch: built for 17 inputs, x and out of %d floats, >= %zu bytes of workspace; got n_in %d, in0 %d, out %d, ws %zu; nothing launched\n", M * DMODEL, (size_t)WS_END, n_in, n_in > 0 ? in_sizes[0] : -1, out_size, ws_size);
            grid = -1; return; }
        int dev = 0, cus = 0, per_cu = 0;
        if (hipGetDevice(&dev) != hipSuccess || hipDeviceGetAttribute(&cus, hipDeviceAttributeMultiprocessorCount, dev) != hipSuccess) { fprintf(stderr, "kernel_launch: device query failed\n"); grid = -1; return; }
        if (hipFuncSetAttribute((const void*)mega_fwd, hipFuncAttributeMaxDynamicSharedMemorySize, LDS_BYTES) != hipSuccess) { fprintf(stderr, "kernel_launch: hipFuncSetAttribute failed\n"); grid = -1; return; }
        if (hipOccupancyMaxActiveBlocksPerMultiprocessor(&per_cu, (const void*)mega_fwd, NWAVES * 64, LDS_BYTES) != hipSuccess || per_cu < 1)
            fprintf(stderr, "kernel_launch: note: occupancy query reports %d workgroups per CU\n", per_cu);
        (void)hipGetLastError();
        grid = cus;
    }
    if (grid < 0) return;
    if (hipMemsetAsync((char*)d_ws + WS_CTL, 0, CTL_ZERO_BYTES, stream) != hipSuccess) { fprintf(stderr, "kernel_launch: memset failed\n"); return; }
    Args a{};
    for (int i = 0; i < 17; ++i) a.in[i] = (const float*)d_in[i];
    a.out = (float*)d_out; a.ws = (unsigned char*)d_ws;
#if MK_MULTI
    for (int p = 0; p < N_PHASES; ++p) { a.ph_lo = p; a.ph_hi = p + 1; hipLaunchKernelGGL(mega_fwd, dim3(grid), dim3(NWAVES * 64), LDS_BYTES, stream, a); }
#else
    a.ph_lo = 0; a.ph_hi = N_PHASES;
    hipLaunchKernelGGL(mega_fwd, dim3(grid), dim3(NWAVES * 64), LDS_BYTES, stream, a);
#endif
    const hipError_t le = hipPeekAtLastError();
    if (le != hipSuccess) fprintf(stderr, "kernel_launch: launch failed: %s\n", hipGetErrorName(le));
}
```

```cpp
#include <hip/hip_runtime.h>
#include <hip/hip_bf16.h>
#include <cstdio>
#include <cstdint>

__device__ __forceinline__ int opaque_tid() { int t = (int)threadIdx.x; asm volatile("" : "+v"(t)); return t; }
__device__ __forceinline__ float xsum16(float v) { const auto r = __builtin_amdgcn_permlane16_swap(__float_as_uint(v), __float_as_uint(v), false, false); return __uint_as_float(r[0]) + __uint_as_float(r[1]); }
__device__ __forceinline__ float xsum32(float v) { const auto r = __builtin_amdgcn_permlane32_swap(__float_as_uint(v), __float_as_uint(v), false, false); return __uint_as_float(r[0]) + __uint_as_float(r[1]); }

__device__ __forceinline__ float shfl_idx(float v, int src) { return __builtin_bit_cast(float, __builtin_amdgcn_ds_bpermute(src << 2, __builtin_bit_cast(int, v))); }

namespace pg8 {
#define PG8_LAS __attribute__((address_space(3)))
typedef unsigned short bf16_t;
typedef short bf16x8 __attribute__((ext_vector_type(8)));
typedef float f32x4 __attribute__((ext_vector_type(4)));
typedef unsigned u32x4 __attribute__((ext_vector_type(4)));
typedef unsigned u32x2 __attribute__((ext_vector_type(2)));
constexpr int BM = 256, BK = 64, HALF = 128, HTB = HALF * BK * 2  , STAGE_BYTES = 8 * HTB, NXCD = 8, WGM = 8;

__host__ __device__ __forceinline__ int lds_byte(int r, int c) { const int st = (r >> 4) * 2 + (c >> 5), rr = r & 15, cc = c & 31, ob = rr * 64 + cc * 2; return st * 1024 + (ob ^ (((ob >> 9) & 1) << 5)); }
__host__ __device__ __forceinline__ void stage_rc(int b, int& R, int& C) { const int st = b / 1024, sb = b % 1024, swz = sb ^ (((sb >> 9) & 1) << 5); R = (st >> 1) * 16 + swz / 64; C = (st & 1) * 32 + (swz % 64) / 2; }
__host__ __device__ __forceinline__ int perm32(int rho) { const int n = rho >> 4, i = rho & 15; return 8 * (i >> 2) + 4 * n + (i & 3); }

struct Unit { int pm, pn, idx; };
struct Gemm { const bf16_t* A; const bf16_t* Bt; int M, N, K; int lda; int a_shift; int a_gbytes; };

struct StaticOrder {
    int nM, nN, nwg, G, c, i0, i1, rowpart;
    __host__ __device__ void init(int M, int N, int G_, int c_, int rowpart_ = 0) { nM = M / BM; nN = N / BM; nwg = nM * nN; G = G_; c = c_; i0 = 0; i1 = 1 << 30; rowpart = rowpart_; }
    __host__ __device__ bool next(int i, Unit& u) const {
        if (i + i0 >= i1) return false;
        if (rowpart) { const int rp = nM >> 3, q = (i + i0) * 32 + (c & 31); if (q >= rp * nN) return false;
            u.pm = (c >> 5) * rp + q % rp; u.pn = q / rp; u.idx = i + i0; return true; }
        const long L = (long)(i + i0) * G + c; if (L >= nwg) return false;
        int wgid = (int)L; { const int q = nwg / NXCD, r = nwg % NXCD, xcd = wgid % NXCD, off = wgid / NXCD; wgid = (xcd < r ? xcd * (q + 1) : r * (q + 1) + (xcd - r) * q) + off; }
        const int nig = WGM * nN, gid = wgid / nig, fm = gid * WGM, gsz = (nM - fm) < WGM ? (nM - fm) : WGM;
        u.pm = fm + ((wgid % nig) % gsz); u.pn = (wgid % nig) / gsz; u.idx = i + i0; return true;
    }
    __device__ __forceinline__ void a_ready(const Unit&) const {}
    __device__ __forceinline__ void done(const Unit&) const {}
};

__device__ __forceinline__ unsigned cvt_pk_bf16(float lo, float hi) { unsigned r; asm volatile("v_cvt_pk_bf16_f32 %0, %1, %2" : "=v"(r) : "v"(lo), "v"(hi)); return r; }

constexpr int DM = 2048;
constexpr int SSQ_PARTS = 32;
constexpr float RMS_EPS = 1e-6f;
__device__ __forceinline__ float row_rstd(const float* ssq, int row, int fq) {
    const f32x4* p = (const f32x4*)(ssq + (size_t)row * SSQ_PARTS + fq * 8);
    const f32x4 a = p[0], b = p[1];
    float s = ((a[0] + a[1]) + (a[2] + a[3])) + ((b[0] + b[1]) + (b[2] + b[3]));
    s = xsum32(xsum16(s));
    return __builtin_amdgcn_rsqf(s * (1.0f / DM) + RMS_EPS);
}

__device__ __forceinline__ void row_rstd8(const float* ssq, int row0, int fq, float (&rs)[2][4]) {
#pragma unroll
    for (int ai = 0; ai < 2; ++ai) {
        f32x4 pa[4], pb[4];
#pragma unroll
        for (int m = 0; m < 4; ++m) { const f32x4* p = (const f32x4*)(ssq + (size_t)(row0 + ai * HALF + m * 16) * SSQ_PARTS + fq * 8); pa[m] = p[0]; pb[m] = p[1]; }
#pragma unroll
        for (int m = 0; m < 4; ++m) { const f32x4 a = pa[m], b = pb[m];
            float s = ((a[0] + a[1]) + (a[2] + a[3])) + ((b[0] + b[1]) + (b[2] + b[3]));
            s = xsum32(xsum16(s));
            rs[ai][m] = __builtin_amdgcn_rsqf(s * (1.0f / DM) + RMS_EPS); }
        asm volatile("" ::: "memory");
    }
}

template <bool SYNC, class Sched> __device__ __forceinline__ void rstd_table(const float* ssq, const Sched& S, PG8_LAS float* rtab, int max_rounds, int tid) {
    for (int idx = tid; idx < max_rounds * BM; idx += 512) {
        Unit u; if (!S.next(idx >> 8, u)) break;
        const f32x4* p = (const f32x4*)(ssq + (size_t)(u.pm * BM + (idx & 255)) * SSQ_PARTS);
        float s = 0.f;
#pragma unroll
        for (int i = 0; i < 8; ++i) { const f32x4 q = p[i]; s += (q[0] + q[1]) + (q[2] + q[3]); }
        rtab[idx] = __builtin_amdgcn_rsqf(s * (1.0f / DM) + RMS_EPS);
    }
    if constexpr (SYNC) { asm volatile("s_waitcnt lgkmcnt(0)" ::: "memory"); __syncthreads(); }
}

struct EpiSwiglu {
    static constexpr bool PERM = true, AFTER_DRAIN = false;
    bf16_t* H; int ldh; PG8_LAS float* rtab; const float* ssq;
    template <class Sched> __device__ __forceinline__ void after_issue(const Sched& S, int tid) const { rstd_table<false>(ssq, S, rtab, 6, tid); }
    __device__ __forceinline__ void operator()(const f32x4 (&acc)[2][2][4][2], const Unit& u, int wr, int wc, int fr, int fq) const {
        const int row0 = u.pm * BM + wr * 64 + fr, col0 = u.pn * HALF + wc * 32 + 8 * fq;
#pragma unroll
        for (int ai = 0; ai < 2; ++ai)
#pragma unroll
            for (int m = 0; m < 4; ++m) {
                const int row = row0 + ai * HALF + m * 16;
                const float rs = rtab[u.idx * BM + wr * 64 + fr + ai * HALF + m * 16];
                const float rs2 = rs * -1.4426950408889634f, irs = __builtin_amdgcn_rcpf(rs * rs);
                float o[8];
#pragma unroll
                for (int n = 0; n < 2; ++n)
#pragma unroll
                    for (int j = 0; j < 4; ++j) {
                        const float ag = acc[ai][0][m][n][j], au = acc[ai][1][m][n][j];
                        const float e = __builtin_amdgcn_exp2f(ag * rs2);
                        o[n * 4 + j] = (ag * au) * __builtin_amdgcn_rcpf(__builtin_fmaf(e, irs, irs));
                    }
                u32x4 w; w.x = cvt_pk_bf16(o[0], o[1]); w.y = cvt_pk_bf16(o[2], o[3]); w.z = cvt_pk_bf16(o[4], o[5]); w.w = cvt_pk_bf16(o[6], o[7]);
                *(u32x4*)(H + (size_t)row * ldh + col0) = w;
            }
    }
};

__device__ __forceinline__ float bf_lo(unsigned w) { return __builtin_bit_cast(float, w << 16); }
__device__ __forceinline__ float bf_hi(unsigned w) { return __builtin_bit_cast(float, w & 0xffff0000u); }
template <bool HALFSTEP  , bool HASVEC  > struct EpiResid {
    static constexpr bool PERM = true, AFTER_DRAIN = false;
    const bf16_t* xb; bf16_t* xo; float* xf; const float* cvec; float* ssq;
    template <class Sched> __device__ __forceinline__ void after_issue(const Sched&, int) const {}
    __device__ __forceinline__ void operator()(const f32x4 (&acc)[2][2][4][2], const Unit& u, int wr, int wc, int fr, int fq) const {
        const int row0 = u.pm * BM + wr * 64 + fr, col0 = u.pn * BM + wc * 32 + 8 * fq;
        constexpr float cs = HALFSTEP ? 0.5f : 1.0f;
        f32x4 cv[2][2];
#pragma unroll
        for (int bj = 0; bj < 2; ++bj)
#pragma unroll
            for (int n = 0; n < 2; ++n) cv[bj][n] = HASVEC ? *(const f32x4*)(cvec + col0 + bj * HALF + 4 * n) * cs : (f32x4){cs, cs, cs, cs};
        u32x4 xr[2][4][2];
#define EPR_LOAD(ai) do { _Pragma("unroll") for (int m = 0; m < 4; ++m) _Pragma("unroll") for (int bj = 0; bj < 2; ++bj) \
            xr[ai][m][bj] = *(const u32x4*)(xb + (size_t)(row0 + (ai) * HALF + m * 16) * DM + col0 + bj * HALF); } while (0)
        EPR_LOAD(0);
        asm volatile("" ::: "memory");
#pragma unroll
        for (int ai = 0; ai < 2; ++ai)
#pragma unroll
            for (int m = 0; m < 4; ++m) {
                if (ai == 0 && m == (HASVEC ? 2 : 0)) { EPR_LOAD(1); asm volatile("" ::: "memory"); }
                const int row = row0 + ai * HALF + m * 16;
                float sq = 0.f;
#pragma unroll
                for (int bj = 0; bj < 2; ++bj) {
                    const u32x4 w = xr[ai][m][bj];
                    const f32x4 x0 = {bf_lo(w.x), bf_hi(w.x), bf_lo(w.y), bf_hi(w.y)}, x1 = {bf_lo(w.z), bf_hi(w.z), bf_lo(w.w), bf_hi(w.w)};
                    const f32x4 n0 = x0 + acc[ai][bj][m][0] * cv[bj][0], n1 = x1 + acc[ai][bj][m][1] * cv[bj][1];
                    sq += ((n0[0] * n0[0] + n0[1] * n0[1]) + (n0[2] * n0[2] + n0[3] * n0[3])) + ((n1[0] * n1[0] + n1[1] * n1[1]) + (n1[2] * n1[2] + n1[3] * n1[3]));
                    const size_t off = (size_t)row * DM + col0 + bj * HALF;
                    if (xf) { *(f32x4*)(xf + off) = n0; *(f32x4*)(xf + off + 4) = n1; }
                    else { u32x4 o; o.x = cvt_pk_bf16(n0[0], n0[1]); o.y = cvt_pk_bf16(n0[2], n0[3]); o.z = cvt_pk_bf16(n1[0], n1[1]); o.w = cvt_pk_bf16(n1[2], n1[3]); *(u32x4*)(xo + off) = o; }
                }
                sq = xsum32(xsum16(sq));
                if (!xf && fq == 0) ssq[(size_t)row * SSQ_PARTS + u.pn * 4 + wc] = sq;
            }
#undef EPR_LOAD
    }
};

struct EpiQKV {
    static constexpr bool PERM = true, AFTER_DRAIN = false;
    bf16_t* Q; size_t tstride; PG8_LAS float* rtab; const float* gqk; PG8_LAS float* xch; const float* ssq;
    template <class Sched> __device__ __forceinline__ void after_issue(const Sched& S, int tid) const { rstd_table<false>(ssq, S, rtab, 3, tid); }
    __device__ __forceinline__ void operator()(const f32x4 (&acc)[2][2][4][2], const Unit& u, int wr, int wc, int fr, int fq) const {
        const int which = u.pn >> 3, hp = u.pn & 7;
        bf16_t* base = Q + (size_t)which * tstride;
        const int row0 = u.pm * BM + wr * 64 + fr, d0 = wc * 32 + 8 * fq, rl0 = wr * 64 + fr;
        float rs[2][4], hs[2][4][2];
#pragma unroll
        for (int ai = 0; ai < 2; ++ai)
#pragma unroll
            for (int m = 0; m < 4; ++m) { rs[ai][m] = rtab[u.idx * BM + rl0 + ai * HALF + m * 16]; hs[ai][m][0] = 1.f; hs[ai][m][1] = 1.f; }
        f32x4 g0 = {1.f, 1.f, 1.f, 1.f}, g1 = {1.f, 1.f, 1.f, 1.f};
        if (which < 2) {
            g0 = *(const f32x4*)(gqk + which * 128 + d0); g1 = *(const f32x4*)(gqk + which * 128 + d0 + 4);
#pragma unroll
            for (int ai = 0; ai < 2; ++ai)
#pragma unroll
                for (int m = 0; m < 4; ++m)
#pragma unroll
                    for (int bj = 0; bj < 2; ++bj) {
                        const f32x4 v0 = acc[ai][bj][m][0], v1 = acc[ai][bj][m][1];
                        float p = ((v0[0] * v0[0] + v0[1] * v0[1]) + (v0[2] * v0[2] + v0[3] * v0[3])) + ((v1[0] * v1[0] + v1[1] * v1[1]) + (v1[2] * v1[2] + v1[3] * v1[3]));
                        p *= rs[ai][m] * rs[ai][m];
                        p = xsum32(xsum16(p));
                        if (fq == 0) xch[((ai * HALF + rl0 + m * 16) * 2 + bj) * 4 + wc] = p;
                    }
            asm volatile("s_waitcnt lgkmcnt(0)" ::: "memory"); __builtin_amdgcn_s_barrier(); asm volatile("" ::: "memory");
#pragma unroll
            for (int ai = 0; ai < 2; ++ai)
#pragma unroll
                for (int m = 0; m < 4; ++m)
#pragma unroll
                    for (int bj = 0; bj < 2; ++bj) {
                        const f32x4 t = *(const PG8_LAS f32x4*)(xch + ((ai * HALF + rl0 + m * 16) * 2 + bj) * 4);
                        hs[ai][m][bj] = __builtin_amdgcn_rsqf(((t[0] + t[1]) + (t[2] + t[3])) * (1.0f / 128.0f) + RMS_EPS);
                    }
        }
#pragma unroll
        for (int ai = 0; ai < 2; ++ai)
#pragma unroll
            for (int m = 0; m < 4; ++m) {
                const int row = row0 + ai * HALF + m * 16;
                const int b = row >> 12, t = row & 4095;
#pragma unroll
                for (int bj = 0; bj < 2; ++bj) {
                    const int h = 2 * hp + bj;
                    const float sc = rs[ai][m] * hs[ai][m][bj];
                    const f32x4 v0 = acc[ai][bj][m][0] * sc * g0, v1 = acc[ai][bj][m][1] * sc * g1;
                    u32x4 w; w.x = cvt_pk_bf16(v0[0], v0[1]); w.y = cvt_pk_bf16(v0[2], v0[3]); w.z = cvt_pk_bf16(v1[0], v1[1]); w.w = cvt_pk_bf16(v1[2], v1[3]);
                    *(u32x4*)(base + (((size_t)(b * 16 + h) * 4096 + t) * 128 + d0)) = w;
                }
            }
    }
};

template <class Epi, class Sched, bool ALIGN_EPI = false, bool SP2 = false>
__device__ __forceinline__ void gemm_phase(PG8_LAS unsigned char* lds, const Gemm g, const Sched& S, const Epi& E) {
    const int tid = opaque_tid(), wid = __builtin_amdgcn_readfirstlane(tid >> 6), lane = tid & 63, wr = wid >> 2, wc = wid & 3, fr = lane & 15, fq = lane >> 4;
    const int K = g.K, nt = K / BK;
    unsigned voffA[2], voffB[2];
#pragma unroll
    for (int i = 0; i < 2; ++i) { int R, C; stage_rc(tid * 16 + i * 8192, R, C); const int Rb = Epi::PERM ? ((R & ~31) + perm32(R & 31)) : R;
        voffA[i] = (unsigned)(R * g.lda + C) * 2u; voffB[i] = (unsigned)(Rb * K + C) * 2u; }
    const unsigned kstep = (unsigned)(BK * 2);
    const unsigned hstepA = (unsigned)HALF * g.lda * 2, hstepB = (unsigned)HALF * K * 2;
    const unsigned tstepA = 2 * hstepA, tstepB = 2 * hstepB;
#define PG8_AOFF(u) ((unsigned)(u).pm * tstepA + (unsigned)((u).pn >> g.a_shift) * (unsigned)g.a_gbytes)
    const __amdgpu_buffer_rsrc_t rsrcA = __builtin_amdgcn_make_buffer_rsrc((void*)g.A, 0, 0x7fffffff, 0x00020000), rsrcB = __builtin_amdgcn_make_buffer_rsrc((void*)g.Bt, 0, 0x7fffffff, 0x00020000);
    const unsigned ldsw = (unsigned)wid * 1024u;
    const int aoff = lds_byte(wr * 64 + fr, fq * 8), boff = lds_byte(wc * 32 + fr, fq * 8);
#define PG8_SA(b, h) (((b) * 2 + (h)) * HTB)
#define PG8_SB(b, h) ((4 + (b) * 2 + (h)) * HTB)
#ifndef PG8_AUX_A
#define PG8_AUX_A 0
#endif
#ifndef PG8_AUX_B
#define PG8_AUX_B 0
#endif
#define PG8_STAGE_X(bufoff, soff, voff, aux, rsrc) do { _Pragma("unroll") for (int _i = 0; _i < 2; ++_i) \
        __builtin_amdgcn_raw_ptr_buffer_load_lds(rsrc, (PG8_LAS unsigned*)(lds + (bufoff) + ldsw + _i * 8192), 16, (int)(voff)[_i], (int)(soff), 0, aux); } while (0)
#define PG8_STAGE_A(bufoff, soff, voff) PG8_STAGE_X(bufoff, soff, voff, PG8_AUX_A, rsrcA)
#define PG8_STAGE_B(bufoff, soff, voff) PG8_STAGE_X(bufoff, soff, voff, PG8_AUX_B, rsrcB)
#define PG8_LDA(dst, b, h) do { _Pragma("unroll") for (int m = 0; m < 4; ++m) _Pragma("unroll") for (int k = 0; k < 2; ++k) dst[m][k] = *(const PG8_LAS bf16x8*)(lds + PG8_SA(b, h) + aoff + m * 2048 + k * 1024); } while (0)
#define PG8_LDB(dst, b, h) do { _Pragma("unroll") for (int n = 0; n < 2; ++n) _Pragma("unroll") for (int k = 0; k < 2; ++k) dst[n][k] = *(const PG8_LAS bf16x8*)(lds + PG8_SB(b, h) + boff + n * 2048 + k * 1024); } while (0)
#define PG8_MMA(ai, bj, At, Bt) do { __builtin_amdgcn_s_setprio(1); _Pragma("unroll") for (int m = 0; m < 4; ++m) _Pragma("unroll") for (int n = 0; n < 2; ++n) _Pragma("unroll") for (int k = 0; k < 2; ++k) \
        acc[ai][bj][m][n] = __builtin_amdgcn_mfma_f32_16x16x32_bf16(Bt[n][k], At[m][k], acc[ai][bj][m][n], 0, 0, 0); __builtin_amdgcn_s_setprio(0); } while (0)
#define PG8_WAIT_V(n) asm volatile("s_waitcnt vmcnt(" #n ")" ::: "memory")
#define PG8_WAIT_L(n) asm volatile("s_waitcnt lgkmcnt(" #n ")" ::: "memory")
#define PG8_BAR __builtin_amdgcn_s_barrier()
#define PG8_SCHED __builtin_amdgcn_sched_barrier(0)
    Unit cur, nxt; int ui = 0;
    if (!S.next(0, cur)) return;
    f32x4 acc[2][2][4][2];
#pragma unroll
    for (int a = 0; a < 2; ++a)
#pragma unroll
        for (int b = 0; b < 2; ++b)
#pragma unroll
            for (int m = 0; m < 4; ++m)
#pragma unroll
                for (int n = 0; n < 2; ++n) acc[a][b][m][n] = (f32x4){0.f, 0.f, 0.f, 0.f};
    bf16x8 At[4][2], B0[2][2], B1[2][2];
    unsigned cA = PG8_AOFF(cur), cB = (unsigned)cur.pn * tstepB;
    S.a_ready(cur);
    if constexpr (SP2) {
        PG8_STAGE_B(PG8_SB(0, 0), cB, voffB); PG8_STAGE_B(PG8_SB(0, 1), cB + hstepB, voffB); PG8_STAGE_A(PG8_SA(0, 0), cA, voffA); PG8_STAGE_A(PG8_SA(0, 1), cA + hstepA, voffA);
        PG8_STAGE_B(PG8_SB(1, 0), cB + kstep, voffB); PG8_STAGE_A(PG8_SA(1, 0), cA + kstep, voffA); PG8_STAGE_B(PG8_SB(1, 1), cB + hstepB + kstep, voffB);
        E.after_issue(S, opaque_tid());
        if (wr == 1) PG8_BAR;
        PG8_WAIT_V(8); PG8_BAR;
        PG8_WAIT_V(6); PG8_BAR;
    } else {
        PG8_STAGE_B(PG8_SB(0, 0), cB, voffB); PG8_STAGE_A(PG8_SA(0, 0), cA, voffA); PG8_STAGE_B(PG8_SB(0, 1), cB + hstepB, voffB); PG8_STAGE_A(PG8_SA(0, 1), cA + hstepA, voffA);
        if (wr == 1) PG8_BAR;
        PG8_WAIT_V(4); PG8_BAR;
        PG8_STAGE_B(PG8_SB(1, 0), cB + kstep, voffB); PG8_STAGE_A(PG8_SA(1, 0), cA + kstep, voffA); PG8_STAGE_B(PG8_SB(1, 1), cB + hstepB + kstep, voffB);
        PG8_WAIT_V(6); PG8_BAR;
    }
    for (;;) {
        const bool has_next = S.next(ui + 1, nxt);
        const unsigned nA = has_next ? PG8_AOFF(nxt) : cA, nB = has_next ? (unsigned)nxt.pn * tstepB : cB;
        for (int t = 0; t < nt; t += 2) {
            const bool last = (t == nt - 2);
            const unsigned a1 = cA + (unsigned)(t + 1) * kstep;
            const unsigned a2 = last ? nA : cA + (unsigned)(t + 2) * kstep, b2 = last ? nB : cB + (unsigned)(t + 2) * kstep;
            const unsigned a3 = a2 + kstep, b3 = b2 + kstep;
            if (last && has_next) S.a_ready(nxt);
            if constexpr (SP2) {
            PG8_STAGE_A(PG8_SA(1, 1), a1 + hstepA, voffA); PG8_SCHED; PG8_LDB(B0, 0, 0); PG8_LDB(B1, 0, 1); PG8_SCHED; PG8_LDA(At, 0, 0);
            PG8_WAIT_V(8); PG8_WAIT_L(0); PG8_BAR; PG8_MMA(0, 0, At, B0); PG8_MMA(0, 1, At, B1); PG8_BAR; PG8_SCHED;
            PG8_STAGE_B(PG8_SB(0, 0), b2, voffB); PG8_STAGE_B(PG8_SB(0, 1), b2 + hstepB, voffB); PG8_STAGE_A(PG8_SA(0, 0), a2, voffA); PG8_SCHED; PG8_LDA(At, 0, 1);
            PG8_WAIT_V(8); PG8_WAIT_L(0); PG8_BAR; PG8_MMA(1, 0, At, B0); PG8_MMA(1, 1, At, B1); PG8_BAR; PG8_SCHED;
            PG8_STAGE_A(PG8_SA(0, 1), a2 + hstepA, voffA); PG8_SCHED; PG8_LDB(B0, 1, 0); PG8_LDB(B1, 1, 1); PG8_SCHED; PG8_LDA(At, 1, 0);
            PG8_WAIT_V(8); PG8_WAIT_L(0); PG8_BAR; PG8_MMA(0, 0, At, B0); PG8_MMA(0, 1, At, B1); PG8_BAR; PG8_SCHED;
            PG8_STAGE_B(PG8_SB(1, 0), b3, voffB); PG8_STAGE_B(PG8_SB(1, 1), b3 + hstepB, voffB); PG8_STAGE_A(PG8_SA(1, 0), a3, voffA); PG8_SCHED; PG8_LDA(At, 1, 1);
            PG8_WAIT_V(8); PG8_WAIT_L(0); PG8_BAR; PG8_MMA(1, 0, At, B0); PG8_MMA(1, 1, At, B1); PG8_BAR; PG8_SCHED;
            } else {
            PG8_LDB(B0, 0, 0); PG8_SCHED; PG8_LDA(At, 0, 0); PG8_STAGE_A(PG8_SA(1, 1), a1 + hstepA, voffA);
            PG8_WAIT_L(8); PG8_BAR; PG8_WAIT_L(0); PG8_MMA(0, 0, At, B0); PG8_BAR; PG8_SCHED;
            PG8_LDB(B1, 0, 1); PG8_STAGE_B(PG8_SB(0, 0), b2, voffB);
            PG8_BAR; PG8_WAIT_L(0); PG8_MMA(0, 1, At, B1); PG8_BAR;
            PG8_LDA(At, 0, 1); PG8_STAGE_A(PG8_SA(0, 0), a2, voffA);
            PG8_BAR; PG8_WAIT_L(0); PG8_MMA(1, 0, At, B0); PG8_BAR; PG8_SCHED;
            PG8_STAGE_B(PG8_SB(0, 1), b2 + hstepB, voffB);
            PG8_WAIT_V(6); PG8_BAR; PG8_MMA(1, 1, At, B1); PG8_BAR;
            PG8_LDB(B0, 1, 0); PG8_SCHED; PG8_LDA(At, 1, 0); PG8_STAGE_A(PG8_SA(0, 1), a2 + hstepA, voffA);
            PG8_WAIT_L(8); PG8_BAR; PG8_WAIT_L(0); PG8_MMA(0, 0, At, B0); PG8_BAR; PG8_SCHED;
            PG8_LDB(B1, 1, 1); PG8_STAGE_B(PG8_SB(1, 0), b3, voffB);
            PG8_BAR; PG8_WAIT_L(0); PG8_MMA(0, 1, At, B1); PG8_BAR;
            PG8_LDA(At, 1, 1); PG8_STAGE_A(PG8_SA(1, 0), a3, voffA);
            PG8_BAR; PG8_WAIT_L(0); PG8_MMA(1, 0, At, B0); PG8_BAR; PG8_SCHED;
            PG8_STAGE_B(PG8_SB(1, 1), b3 + hstepB, voffB);
            PG8_WAIT_V(6); PG8_BAR; PG8_MMA(1, 1, At, B1); PG8_BAR;
            }
        }
        if constexpr (ALIGN_EPI) { if (wr == 0) PG8_BAR; }
        if constexpr (!Epi::AFTER_DRAIN) { const int t2 = opaque_tid(), w2 = __builtin_amdgcn_readfirstlane(t2 >> 6);
            E(acc, cur, w2 >> 2, w2 & 3, t2 & 15, (t2 & 63) >> 4); S.done(cur); }
        if (!has_next) break;
#pragma unroll
        for (int a = 0; a < 2; ++a)
#pragma unroll
            for (int b = 0; b < 2; ++b)
#pragma unroll
                for (int m = 0; m < 4; ++m)
#pragma unroll
                    for (int n = 0; n < 2; ++n) acc[a][b][m][n] = (f32x4){0.f, 0.f, 0.f, 0.f};
        cur = nxt; cA = nA; cB = nB; ++ui;
        if constexpr (ALIGN_EPI) { if (wr == 1) PG8_BAR; }
    }
    PG8_WAIT_V(0);
    if constexpr (!ALIGN_EPI) { if (wr == 0) PG8_BAR; }
    PG8_BAR;
    if constexpr (Epi::AFTER_DRAIN) { E.fused(acc, cur, wr, wc, fr, fq, lds, wid, lane); S.done(cur); }
#undef PG8_AOFF
#undef PG8_SA
#undef PG8_SB
#undef PG8_STAGE_X
#undef PG8_STAGE_A
#undef PG8_STAGE_B
#undef PG8_LDA
#undef PG8_LDB
#undef PG8_MMA
#undef PG8_WAIT_V
#undef PG8_WAIT_L
#undef PG8_BAR
#undef PG8_SCHED
}
}
namespace fox {
typedef unsigned short bf16;
typedef short bf16x8 __attribute__((ext_vector_type(8)));
typedef short s16x4 __attribute__((ext_vector_type(4)));
typedef float f32x16 __attribute__((ext_vector_type(16)));
typedef float f32x4 __attribute__((ext_vector_type(4)));
typedef unsigned u32x4 __attribute__((ext_vector_type(4)));
constexpr int D = 128, T = 4096, NH = 16, OLD = 2048;
constexpr int NW = 8, QBLK = 32, KVBLK = 64, QB = NW * QBLK;
constexpr int SHM_V = KVBLK * D * 2, SHM_K = KVBLK * D * 2;
constexpr int LDS_WS = 2 * SHM_V + 2 * SHM_K, LDS_F = LDS_WS + NW * 64 * 4, LDS_BYTES = LDS_F + T * 4;
constexpr float THR = 8.f;
constexpr float LOG2E = 1.4426950408889634f;
constexpr float QSCALE = LOG2E * 0.08838834764831845f;

#define KSWZ(row, colB) ((row) * 256 + ((colB) ^ (((row) & 7) << 4)))
#define SBAR() __builtin_amdgcn_sched_barrier(0)
__device__ __forceinline__ int v_st(int k, int c) { const int kk = (k & ~0xC) | ((k & 4) << 1) | ((k & 8) >> 1); return ((kk >> 3) * 4 + (c >> 5)) * 512 + ((kk & 7) * 32 + (c & 31)) * 2; }
__device__ __forceinline__ int v_rd_base(int lane) { return ((lane & 3) << 3) | (((lane >> 2) & 3) << 6) | (((lane >> 4) & 1) << 5) | (((lane >> 5) & 1) << 8); }
constexpr int v_rd_off(int d0, int ks, int half) { return d0 * 512 + ks * 4096 + half * 2048; }
__device__ __forceinline__ int crow(int r, int hi) { return (r & 3) + 8 * (r >> 2) + 4 * hi; }
__device__ __forceinline__ unsigned cvtpk(float lo, float hi) {
    unsigned r; asm volatile("v_cvt_pk_bf16_f32 %0, %1, %2" : "=v"(r) : "v"(lo), "v"(hi)); return r;
}
__device__ __forceinline__ bf16x8 load8(const bf16* p) { return *reinterpret_cast<const bf16x8*>(p); }
__device__ __forceinline__ void mask_tile(f32x16& p0, f32x16& p1, int dq) {
    const float NEG = -__builtin_inff();
#pragma unroll
    for (int r = 0; r < 16; ++r) {
        const int c = (r & 3) + 8 * (r >> 2);
        if (dq - c < 0) p0[r] = NEG;
        if (dq - c - 32 < 0) p1[r] = NEG;
    }
}
__device__ __forceinline__ void partialSM(f32x16& p0, f32x16& p1, float& m_reg, float& mn, float& alpha) {
    float pmax = p0[0];
#pragma unroll
    for (int r = 1; r < 16; ++r) pmax = fmaxf(pmax, p0[r]);
#pragma unroll
    for (int r = 0; r < 16; ++r) pmax = fmaxf(pmax, p1[r]);
    { auto rr = __builtin_amdgcn_permlane32_swap(__float_as_uint(pmax), __float_as_uint(pmax), false, false);
      pmax = fmaxf(__uint_as_float(rr[0]), __uint_as_float(rr[1])); }
    if (__builtin_expect(__all((pmax - m_reg) <= THR), 1)) { mn = m_reg; alpha = 1.f; }
    else { mn = fmaxf(m_reg, pmax); alpha = __builtin_amdgcn_exp2f(m_reg - mn); m_reg = mn; }
#pragma unroll
    for (int r = 0; r < 16; ++r) p0[r] = p0[r] - mn;
#pragma unroll
    for (int r = 0; r < 16; ++r) p1[r] = p1[r] - mn;
#pragma unroll
    for (int r = 0; r < 16; ++r) p0[r] = __builtin_amdgcn_exp2f(p0[r]);
}
__device__ __forceinline__ void finishSM(f32x16& p0, f32x16& p1, float alpha, float& l_reg, bf16x8& pa0, bf16x8& pa1, bf16x8& pa2, bf16x8& pa3) {
#pragma unroll
    for (int r = 0; r < 16; ++r) p1[r] = __builtin_amdgcn_exp2f(p1[r]);
    float ps = 0;
#pragma unroll
    for (int r = 0; r < 16; ++r) ps += p0[r];
#pragma unroll
    for (int r = 0; r < 16; ++r) ps += p1[r];
    { auto rr = __builtin_amdgcn_permlane32_swap(__float_as_uint(ps), __float_as_uint(ps), false, false);
      ps = __uint_as_float(rr[0]) + __uint_as_float(rr[1]); }
    l_reg = l_reg * alpha + ps;
#define PK4(P, B_, OUT) do { unsigned a0 = cvtpk(P[B_+0], P[B_+1]), a1 = cvtpk(P[B_+2], P[B_+3]);                          \
        unsigned b0 = cvtpk(P[B_+4], P[B_+5]), b1 = cvtpk(P[B_+6], P[B_+7]);                                             \
        auto r0 = __builtin_amdgcn_permlane32_swap(a0, b0, false, false); auto r1 = __builtin_amdgcn_permlane32_swap(a1, b1, false, false); \
        u32x4 w = {r0[0], r1[0], r0[1], r1[1]}; OUT = *reinterpret_cast<bf16x8*>(&w); } while (0)
    PK4(p0, 0, pa0); PK4(p0, 8, pa1); PK4(p1, 0, pa2); PK4(p1, 8, pa3);
#undef PK4
}
template <int KB>
__device__ __forceinline__ void qkt(f32x16& p0, f32x16& p1, const char* K_lds, int r32, int hi, const bf16x8* qr, float fqv, const float* fk) {
#pragma unroll
    for (int g = 0; g < 4; ++g) {
        const f32x4 a = *reinterpret_cast<const f32x4*>(fk + 8 * g), b = *reinterpret_cast<const f32x4*>(fk + 32 + 8 * g);
#pragma unroll
        for (int j = 0; j < 4; ++j) { p0[4 * g + j] = fqv - a[j]; p1[4 * g + j] = fqv - b[j]; }
    }
    const char* kb[4];
#pragma unroll
    for (int dd = 0; dd < 4; ++dd) kb[dd] = K_lds + KB * SHM_K + KSWZ(r32, (dd * 16 + hi * 8) * 2);
#pragma unroll
    for (int d0 = 0; d0 < 8; ++d0) { const char* a = kb[d0 & 3] + (d0 >> 2) * 128;
        bf16x8 b0 = *reinterpret_cast<const bf16x8*>(a);
        bf16x8 b1 = *reinterpret_cast<const bf16x8*>(a + 32 * 256);
        p0 = __builtin_amdgcn_mfma_f32_32x32x16_bf16(b0, qr[d0], p0, 0, 0, 0);
        p1 = __builtin_amdgcn_mfma_f32_32x32x16_bf16(b1, qr[d0], p1, 0, 0, 0); }
}
template <int VB>
__device__ __forceinline__ void pv_tile(f32x16* o, int vb0, bf16x8 pa0, bf16x8 pa1, bf16x8 pa2, bf16x8 pa3) {
#define TRRD(dst, off) asm volatile("ds_read_b64_tr_b16 %0, %1 offset:%2" : "=&v"(dst) : "v"(vb0), "i"(off) : "memory")
#define PV_D0(d0) do { s16x4 l0, l1, l2, l3, h0, h1, h2, h3; constexpr int b_ = VB * SHM_V + v_rd_off(d0, 0, 0);     \
        TRRD(l0, b_); TRRD(h0, b_ + 2048); TRRD(l1, b_ + 4096); TRRD(h1, b_ + 6144); TRRD(l2, b_ + 8192); TRRD(h2, b_ + 10240); TRRD(l3, b_ + 12288); TRRD(h3, b_ + 14336); \
        asm volatile("s_waitcnt lgkmcnt(0)" ::: "memory"); SBAR();                 \
        o[d0] = __builtin_amdgcn_mfma_f32_32x32x16_bf16(pa0, (bf16x8){l0[0], l0[1], l0[2], l0[3], h0[0], h0[1], h0[2], h0[3]}, o[d0], 0, 0, 0);   \
        o[d0] = __builtin_amdgcn_mfma_f32_32x32x16_bf16(pa1, (bf16x8){l1[0], l1[1], l1[2], l1[3], h1[0], h1[1], h1[2], h1[3]}, o[d0], 0, 0, 0);   \
        o[d0] = __builtin_amdgcn_mfma_f32_32x32x16_bf16(pa2, (bf16x8){l2[0], l2[1], l2[2], l2[3], h2[0], h2[1], h2[2], h2[3]}, o[d0], 0, 0, 0);   \
        o[d0] = __builtin_amdgcn_mfma_f32_32x32x16_bf16(pa3, (bf16x8){l3[0], l3[1], l3[2], l3[3], h3[0], h3[1], h3[2], h3[3]}, o[d0], 0, 0, 0); } while (0)
    PV_D0(0); PV_D0(1); PV_D0(2); PV_D0(3);
#undef PV_D0
#undef TRRD
}

struct BlockRef { const bf16* Q; const bf16* K; const bf16* V; bf16* O; int P0; int JLO; float THR; };
struct Stage { bf16x8 st_v0, st_v1, st_k0, st_k1; };
struct Seam { bf16x8 qr[8]; bf16x8 st_v0, st_v1, st_k0, st_k1; };
#define ROW(p, k0, rr) ((p) + (size_t)((k0) + (rr)) * D + sc)
#define VMW() asm volatile("s_waitcnt vmcnt(0)" ::: "memory")
#define VMWN(n) asm volatile("s_waitcnt vmcnt(%0)" :: "i"(n) : "memory")
#define SLOAD_X(X, Kp, Vp, k0) do { X.st_v0 = load8(ROW(Vp, k0, sr)); X.st_v1 = load8(ROW(Vp, k0, 32 + sr));              \
                         X.st_k0 = load8(ROW(Kp, k0, sr)); X.st_k1 = load8(ROW(Kp, k0, 32 + sr)); } while (0)
#define SWRITE_XK(X, bf) do { *(bf16x8*)(K_lds + (bf) * SHM_K + kws) = X.st_k0; *(bf16x8*)(K_lds + (bf) * SHM_K + kws + 32 * 256) = X.st_k1; } while (0)
#define SWRITE_XV(X, bf) do { *(bf16x8*)(V_lds + (bf) * SHM_V + vst0) = X.st_v0; *(bf16x8*)(V_lds + (bf) * SHM_V + vst1) = X.st_v1; } while (0)
#define SWRITE_X(X, bf) do { SWRITE_XV(X, bf); SWRITE_XK(X, bf); } while (0)
#define SLOAD_H(Kp, Vp, k0) SLOAD_X(S, Kp, Vp, k0)
#define SWRITE_HK(bf) SWRITE_XK(S, bf)
#define SWRITE_HV(bf) SWRITE_XV(S, bf)
#define SWRITE_H(bf) SWRITE_X(S, bf)
__device__ __forceinline__ void fox_prime(const BlockRef& cur, char* lds, Seam& S) {
    const int tid = opaque_tid(), wid = __builtin_amdgcn_readfirstlane(tid >> 6), lane = tid & 63, r32 = lane & 31, hi = lane >> 5;
    const int sr = tid >> 4, sc = (tid & 15) * 8, kws = KSWZ(sr, sc * 2); char* K_lds = lds + 2 * SHM_V;
    const int kb0 = cur.JLO * KVBLK;
#pragma unroll
    for (int d0 = 0; d0 < 8; ++d0) S.qr[d0] = load8(cur.Q + (size_t)(wid * QBLK + r32) * D + d0 * 16 + hi * 8);
    SLOAD_H(cur.K, cur.V, kb0); VMW(); SWRITE_HK(0);
    __syncthreads();
}
__device__ __forceinline__ void fox_block(const BlockRef& cur, const BlockRef& nxt, char* lds, Seam& S) {
    const int tid = opaque_tid(), wid = __builtin_amdgcn_readfirstlane(tid >> 6), lane = tid & 63, r32 = lane & 31, hi = lane >> 5;
    const int j_lo = cur.JLO;
    const int j_hi = (cur.P0 + QB - 1) / KVBLK + 1;
    const int NT = j_hi - j_lo;
    const int kbn = nxt.JLO * KVBLK;
    const int qlo = cur.P0 + wid * QBLK, qm = qlo + r32 - 4 * hi;
    char* V_lds = lds; char* K_lds = lds + 2 * SHM_V;
    float* ws = (float*)(lds + LDS_WS) + wid * 64; float* li_l = ws, * al_l = ws + 32;
    const float* Fl = (const float*)(lds + LDS_F);
    const float fqv = Fl[qlo + r32];
    int tl_w = 0;
    if (cur.THR >= 0.f) {
        const bool dead = (KVBLK * lane + KVBLK - 1 < qlo) && (Fl[qlo] - Fl[KVBLK * lane + KVBLK - 1] <= -cur.THR);
        const int jw = __builtin_amdgcn_readfirstlane((int)__builtin_ctzll(~__ballot(dead)));
        tl_w = jw > j_lo ? jw - j_lo : 0;
    }
    const int th_w_ = (qlo + QBLK - 1) / KVBLK + 1 - j_lo, th_w = th_w_ < NT ? th_w_ : NT;
    float m_reg = -1e30f, l_reg = 0; f32x16 o[4] = {};
    const int sr = tid >> 4, sc = (tid & 15) * 8, vst0 = v_st(sr, sc), vst1 = v_st(32 + sr, sc), kws = KSWZ(sr, sc * 2);
    const int vb0 = (int)(uintptr_t)V_lds + v_rd_base(lane);
    const bf16* Kh = cur.K; const bf16* Vh = cur.V;
#define RESC(a) do { if (__any((a) < 1.f)) { if (hi == 0) al_l[r32] = (a); asm volatile("s_waitcnt lgkmcnt(0)" ::: "memory");              \
                     for (int d_ = 0; d_ < 4; ++d_) for (int r = 0; r < 16; ++r) o[d_][r] *= al_l[crow(r, hi)]; } } while (0)
#define KBASE(t) ((j_lo + (t)) * KVBLK)
#define FK(t) (Fl + KBASE(t) + 4 * hi)
#define MASKT(P0_, P1_, t) do { const int kb_ = KBASE(t); if (kb_ + KVBLK - 1 > qlo) mask_tile(P0_, P1_, qm - kb_); } while (0)
    Stage T;
    SWRITE_HV(0);
    if (NT > 1) SLOAD_X(T, Kh, Vh, KBASE(1));
    __syncthreads();
    f32x16 p0, p1; float mn, al; bf16x8 pa0, pa1, pa2, pa3;
#define TILE(t, B, XB, XN) do {                                                                                                \
        if ((t) + 2 < NT) { SLOAD_X(XB, Kh, Vh, KBASE((t) + 2)); SBAR(); }                                                      \
        if ((t) >= tl_w && (t) < th_w) {                                                                                        \
        qkt<B>(p0, p1, K_lds, r32, hi, S.qr, fqv, FK(t)); MASKT(p0, p1, (t)); partialSM(p0, p1, m_reg, mn, al); RESC(al);      \
        finishSM(p0, p1, al, l_reg, pa0, pa1, pa2, pa3); SBAR(); pv_tile<B>(o, vb0, pa0, pa1, pa2, pa3); }                     \
        if ((t) + 1 < NT) { if ((t) + 2 < NT) VMWN(4); else VMW(); SWRITE_X(XN, 1 - (B)); }                                     \
        __syncthreads(); } while (0)
    int t = 0;
    for (; t + 1 < NT; t += 2) { TILE(t, 0, S, T); TILE(t + 1, 1, T, S); }
    if (t < NT) TILE(t, 0, S, T);
    SLOAD_H(nxt.K, nxt.V, kbn); SBAR();
#pragma unroll
    for (int d0 = 0; d0 < 8; ++d0) S.qr[d0] = load8(nxt.Q + (size_t)(wid * QBLK + r32) * D + d0 * 16 + hi * 8);
    SBAR();
    VMWN(8); SWRITE_HK(0); SBAR();
    if (hi == 0) li_l[r32] = l_reg; asm volatile("s_waitcnt lgkmcnt(0)" ::: "memory");
    float rli[16];
#pragma unroll
    for (int r = 0; r < 16; ++r) rli[r] = __builtin_amdgcn_rcpf(li_l[crow(r, hi)]);
    bf16* Ow = cur.O + (size_t)(wid * QBLK) * OLD;
    char* ost = lds + LDS_BYTES + wid * 4096;
#pragma unroll
    for (int ps = 0; ps < 2; ++ps) {
#pragma unroll
        for (int r = 0; r < 16; ++r) { const int orow = crow(r, hi);
#pragma unroll
            for (int dd = 0; dd < 2; ++dd) { const float v = o[2 * ps + dd][r] * rli[r];
                *(unsigned short*)(ost + orow * 128 + (dd * 32 + r32) * 2) = (unsigned short)cvtpk(v, v); } }
        asm volatile("s_waitcnt lgkmcnt(0)" ::: "memory");
#pragma unroll
        for (int i = 0; i < 4; ++i) { const int row = (lane >> 3) + 8 * i, ch = lane & 7;
            const u32x4 w = *(const u32x4*)(ost + row * 128 + ch * 16);
            *(u32x4*)(Ow + (size_t)row * OLD + ps * 64 + ch * 8) = w; }
        asm volatile("s_waitcnt lgkmcnt(0)" ::: "memory");
    }
    __syncthreads();
#undef RESC
#undef KBASE
#undef FK
#undef MASKT
#undef TILE
}
#undef ROW
#undef VMW
#undef VMWN
#undef SLOAD_H
#undef SWRITE_HK
#undef SWRITE_HV
#undef SWRITE_H
#undef SLOAD_X
#undef SWRITE_XK
#undef SWRITE_XV
#undef SWRITE_X
#undef SBAR
#undef KSWZ
}

#define GAS __attribute__((address_space(1)))
#define LAS __attribute__((address_space(3)))
typedef unsigned short bf16;
typedef unsigned v4u __attribute__((ext_vector_type(4)));
typedef float f32x4 __attribute__((ext_vector_type(4)));
typedef short bf16x8 __attribute__((ext_vector_type(8)));
typedef GAS unsigned gu32;
typedef GAS unsigned long long gu64;
#define RLX_AGENT __ATOMIC_RELAXED, __HIP_MEMORY_SCOPE_AGENT
#define LDS_WAIT() asm volatile("s_waitcnt lgkmcnt(0)" ::: "memory")
#define VM_WAIT() asm volatile("s_waitcnt vmcnt(0)" ::: "memory")
__device__ __forceinline__ unsigned long long rt() { return __builtin_amdgcn_s_memrealtime(); }
__device__ __forceinline__ unsigned f2bf(float f) { unsigned u = __builtin_bit_cast(unsigned, f); return (u + 0x7fffu + ((u >> 16) & 1u)) >> 16; }
__device__ __forceinline__ unsigned pk2(float lo, float hi) { return f2bf(lo) | (f2bf(hi) << 16); }

#define XB_TMO      128
#define XB_XCNT(j)  (256  + 64 * (j))
#define XB_XSUB(j)  (1280 + 64 * (j))
#define XB_XGEN(j)  (2304 + 64 * (j))
#define XB_TOP      3328
#define XB_TOPGEN   3392
#define XCD_BAR_WORDS 3456
#define XB_SPIN_CAP (1u << 21)

__device__ __forceinline__ unsigned xb_ld(unsigned* p)              { return __hip_atomic_load(p, __ATOMIC_RELAXED, __HIP_MEMORY_SCOPE_AGENT); }
__device__ __forceinline__ unsigned xb_add(unsigned* p, unsigned v) { return __hip_atomic_fetch_add(p, v, __ATOMIC_RELAXED, __HIP_MEMORY_SCOPE_AGENT); }
__device__ __forceinline__ unsigned xb_xcc_id() { return (unsigned)__builtin_amdgcn_s_getreg((3 << 11) | 20) & 0xFu; }
#define XB_SPIN(cond, bar) do { unsigned _sp = 0; while (cond) { __builtin_amdgcn_s_sleep(1); \
    if ((++_sp & 255u) == 0u) { if (xb_ld(&(bar)[XB_TMO])) break; if (_sp > XB_SPIN_CAP) { atomicAdd(&(bar)[XB_TMO], 1u); break; } } } } while (0)

struct XcdBarrier {
    unsigned* bar; unsigned x;
    volatile LAS unsigned* st;
};

__device__ __forceinline__ XcdBarrier xcd_barrier_post(unsigned* bar, volatile LAS unsigned* st) {
    XcdBarrier b; b.bar = bar; b.x = xb_xcc_id(); b.st = st;
    if (threadIdx.x == 0) st[3] = xb_add(&bar[XB_XCNT(b.x)], 1u);
    return b;
}
__device__ __forceinline__ void xcd_barrier_complete(unsigned* bar, unsigned x, unsigned& nloc, unsigned& nx, unsigned& even) {
    const unsigned G = gridDim.x * gridDim.y * gridDim.z;
    unsigned sum, cnt, mine, n32, sp = 0u;
    for (;;) {
        sum = 0u; cnt = 0u; mine = 0u; n32 = 0u;
#pragma unroll
        for (unsigned j = 0; j < 16; ++j) { const unsigned c = xb_ld(&bar[XB_XCNT(j)]); sum += c; cnt += (c > 0u) ? 1u : 0u; mine = (j == x) ? c : mine; n32 += (j < 8u && c == 32u) ? 1u : 0u; }
        even = (sum == G && n32 == 8u && G == 256u) ? 1u : 2u;
        if (sum == G) break;
        __builtin_amdgcn_s_sleep(1);
        if ((++sp & 255u) == 0u) { if (xb_ld(&bar[XB_TMO])) break; if (sp > XB_SPIN_CAP) { atomicAdd(&bar[XB_TMO], 1u); break; } }
    }
    nloc = mine > 0u ? mine : 1u; nx = cnt > 0u ? cnt : 1u;
}

__device__ __forceinline__ void xcd_barrier(const XcdBarrier& b) {
    asm volatile("s_waitcnt vmcnt(0)" ::: "memory");
    __syncthreads();
    if (threadIdx.x == 0) {
        unsigned* bar = b.bar;
        __builtin_amdgcn_s_waitcnt(0);
        unsigned nloc = b.st[0], nx = b.st[1];
        if (nloc == 0u) { unsigned even; xcd_barrier_complete(bar, b.x, nloc, nx, even); b.st[0] = nloc; b.st[1] = nx; b.st[2] = even; }
        const unsigned old = xb_add(&bar[XB_XSUB(b.x)], 1u);
        const unsigned gen = old / nloc;
        if (old + 1u == (gen + 1u) * nloc) {
            __builtin_amdgcn_fence(__ATOMIC_RELEASE, "agent");
            asm volatile("s_waitcnt vmcnt(0)" ::: "memory");
            const unsigned og = xb_add(&bar[XB_TOP], 1u);
            const unsigned tg = og / nx;
            if (og + 1u == (tg + 1u) * nx) xb_add(&bar[XB_TOPGEN], 1u);
            else XB_SPIN(xb_ld(&bar[XB_TOPGEN]) == tg, bar);
            __builtin_amdgcn_fence(__ATOMIC_ACQUIRE, "agent");
            xb_add(&bar[XB_XGEN(b.x)], 1u);
            asm volatile("s_waitcnt vmcnt(0)" ::: "memory");
        } else {
            XB_SPIN(xb_ld(&bar[XB_XGEN(b.x)]) == gen, bar);
            __builtin_amdgcn_fence(__ATOMIC_ACQUIRE, "agent");
            asm volatile("s_waitcnt vmcnt(0)" ::: "memory");
        }
    }
    __syncthreads();
}

__device__ __forceinline__ void xcd_local_barrier(const XcdBarrier& b) {
    asm volatile("s_waitcnt vmcnt(0)" ::: "memory");
    __syncthreads();
    if (threadIdx.x == 0) {
        unsigned* bar = b.bar;
        __builtin_amdgcn_s_waitcnt(0);
        const unsigned nloc = b.st[0];
        const unsigned old = xb_add(&bar[XB_XSUB(b.x)], 1u);
        const unsigned gen = old / nloc;
        if (old + 1u == (gen + 1u) * nloc) xb_add(&bar[XB_XGEN(b.x)], 1u);
        else XB_SPIN(xb_ld(&bar[XB_XGEN(b.x)]) == gen, bar);
        __builtin_amdgcn_fence(__ATOMIC_ACQUIRE, "agent");
        asm volatile("s_waitcnt vmcnt(0)" ::: "memory");
    }
    __syncthreads();
}

constexpr int NWAVES = 8;
constexpr int BATCH = 2, SEQ = 4096, DMODEL = 2048, DFF = 5632, DEPTH = 4, NHEAD = 16, HDIM = 128;
constexpr int M = BATCH * SEQ;
constexpr int NGU = 2 * DFF;
constexpr int NQKV = 3 * DMODEL;
constexpr int WIN_LD = 3 * DMODEL + NHEAD;
#ifndef MK_MULTI
#define MK_MULTI 0
#endif
#ifndef PROBE_AMP
#define PROBE_AMP 1
#endif
#ifndef PROBE_CLASS
#define PROBE_CLASS -1
#endif
constexpr int N_PHASES = 1 + 16 + 4 + 6;
#ifndef FOX_SKIP
#define FOX_SKIP 1
#endif

constexpr size_t MiB = 1u << 20;
constexpr size_t WS_CTL = 0, CTL_ZERO_BYTES = 16384;
constexpr size_t SZ_WGU = (size_t)NGU * DMODEL * 2, SZ_WD = (size_t)DMODEL * DFF * 2;
constexpr size_t SZ_WFIN = (size_t)NQKV * DMODEL * 2, SZ_WFOUT = (size_t)DMODEL * DMODEL * 2, SZ_WPOOL = (size_t)DMODEL * 512 * 2;
constexpr size_t WS_WGU = 1 * MiB;
constexpr size_t WS_WD = WS_WGU + 8 * SZ_WGU;
constexpr size_t WS_WFIN = WS_WD + 8 * SZ_WD;
constexpr size_t WS_WFOUT = WS_WFIN + 2 * SZ_WFIN;
constexpr size_t WS_WPOOL = WS_WFOUT + 2 * SZ_WFOUT;
constexpr size_t WS_WFT = WS_WPOOL + 2 * SZ_WPOOL;
constexpr size_t WS_GQK = WS_WFT + 2 * 16 * 2048 * 4;
constexpr size_t WS_SSQ = WS_GQK + 4096;
constexpr size_t WS_LF = WS_SSQ + (size_t)M * 32 * 4;
constexpr size_t WS_XG = WS_LF + (size_t)32 * 4096 * 4;
constexpr size_t WS_HACT = WS_XG + (size_t)M * DMODEL * 2;
constexpr size_t WS_Q = WS_HACT + (size_t)M * DFF * 2;
constexpr size_t WS_K = WS_Q + (size_t)M * DMODEL * 2;
constexpr size_t WS_V = WS_K + (size_t)M * DMODEL * 2;
constexpr size_t WS_O = WS_V + (size_t)M * DMODEL * 2;
constexpr size_t WS_XG2 = WS_O + (size_t)M * DMODEL * 2;
constexpr size_t WS_SSQ2 = WS_XG2 + (size_t)M * DMODEL * 2;
constexpr size_t WS_END = WS_SSQ2 + (size_t)M * 32 * 4;
static_assert(WS_WGU % 256 == 0 && WS_WD % 256 == 0 && WS_WFIN % 256 == 0 && WS_XG % 256 == 0 && WS_HACT % 256 == 0 && WS_Q % 256 == 0 && WS_O % 256 == 0 && WS_XG2 % 256 == 0 && WS_SSQ2 % 256 == 0, "alignment");
constexpr int CW_BAR = 0;

constexpr int RING_OFF = 0, RING_BYTES = 131072;
constexpr int LDSCTL_OFF = RING_BYTES, MISC_OFF = LDSCTL_OFF + 320, XCH_OFF = LDSCTL_OFF + 1024, RTAB_OFF = XCH_OFF + 8192;
constexpr int LDS_BYTES = 147456;
static_assert(MISC_OFF + 128 <= XCH_OFF && RTAB_OFF + 6 * 256 * 4 <= LDS_BYTES && fox::LDS_BYTES + 8 * 4096 <= RING_BYTES, "LDS map (the attention body adds a 4 KiB O stage per wave above its own LDS)");


struct Args { const float* in[17]; float* out; unsigned char* ws; int ph_lo, ph_hi; };
struct Frame {
    LAS unsigned char* lds;
    volatile LAS unsigned* MISC;
    gu32* ctl;
    int tid, lane, wave, vcu, G, rowpart;
};
typedef unsigned long long u64_t;
#define GIN(a_, k_) ((const float*)(const GAS float*)(a_).in[k_])
__device__ __forceinline__ float wave_sum(float v, int lane) {
#pragma unroll
    for (int o = 1; o < 64; o <<= 1) v += shfl_idx(v, lane ^ o);
    return v;
}
__device__ __forceinline__ float bf2f(unsigned short u) { return __builtin_bit_cast(float, (unsigned)u << 16); }

struct CvItem { const float* src; int ldw; bf16* dst; int kd; const float* gk; };
constexpr int CV_FFN = 3 * 5632, CV_FOX = 6144 + 2048, CV_POOL = 4 * 128;
#ifndef CV_SPLIT
#define CV_SPLIT(bx_) 5
#endif
constexpr int CV_TAIL = 13400;
constexpr int CV_PRO = 8 * CV_FFN + 2 * CV_FOX + 2 * CV_POOL - 7 * CV_TAIL;
constexpr int CV_TOTAL = 8 * CV_FFN + 2 * CV_FOX + 2 * CV_POOL;
constexpr int cv_reader_phase(int g) {
    constexpr int gu_ph[8] = {1, 5, 7, 12, 14, 18, 20, 25};
    if (g < CV_FFN) return gu_ph[0];
    g -= CV_FFN; if (g < CV_POOL) return 4;
    g -= CV_POOL; if (g < CV_FFN) return gu_ph[1];
    g -= CV_FFN; if (g < CV_FOX) return 9;
    g -= CV_FOX; if (g < 2 * CV_FFN) return gu_ph[2 + g / CV_FFN];
    g -= 2 * CV_FFN; if (g < CV_POOL) return 17;
    g -= CV_POOL; if (g < 2 * CV_FFN) return gu_ph[4 + g / CV_FFN];
    g -= 2 * CV_FFN; if (g < CV_FOX) return 22;
    g -= CV_FOX; return gu_ph[6 + g / CV_FFN];
}
constexpr bool cv_seams_ok() {
    constexpr int gu_ph[8] = {1, 5, 7, 12, 14, 18, 20, 25};
    constexpr int grid_after[8] = {0, 2, 9, 15, 19, 22, 22, 22};
    for (int s = 0; s < 7; ++s) {
        const int lo = CV_PRO + s * CV_TAIL, hi = lo + CV_TAIL;
        int first = 1000;
        for (int g = lo; g < hi; g += 64) { const int r = cv_reader_phase(g); if (r < first) first = r; }
        { const int r = cv_reader_phase(hi - 1); if (r < first) first = r; }
        bool ok = false;
        for (int k = 0; k < 8; ++k) if (grid_after[k] >= gu_ph[s] && grid_after[k] < first) ok = true;
        if (!ok) return false;
    }
    return true;
}
__device__ __forceinline__ CvItem cv_ffn(const Args& a, unsigned char* ws, int s, int q) {
    const int mat = q / 5632, i = q % 5632, L = s >> 1, f = s & 1; CvItem it;
    if (mat < 2) {
        const int kb = i / 176, nb = i % 176, n0 = 32 * nb;
        const float* Wm = (mat == 0 ? (f ? GIN(a, 14) : GIN(a, 2)) : (f ? GIN(a, 15) : GIN(a, 3))) + (size_t)L * DMODEL * DFF;
        it.src = Wm + (size_t)(64 * kb) * DFF + n0; it.ldw = DFF; it.gk = (f ? GIN(a, 13) : GIN(a, 1)) + (size_t)L * DMODEL + 64 * kb;
        const int drow = (n0 >> 7) * 256 + (n0 & 127) + mat * 128;
        it.dst = (bf16*)(ws + WS_WGU + (size_t)s * SZ_WGU) + (size_t)drow * DMODEL + 64 * kb; it.kd = DMODEL;
    } else {
        const int kb = i / 64, nb = i % 64, n0 = 32 * nb;
        const float* Wm = (f ? GIN(a, 16) : GIN(a, 4)) + (size_t)L * DFF * DMODEL;
        it.src = Wm + (size_t)(64 * kb) * DMODEL + n0; it.ldw = DMODEL; it.gk = nullptr;
        it.dst = (bf16*)(ws + WS_WD + (size_t)s * SZ_WD) + (size_t)n0 * DFF + 64 * kb; it.kd = DFF;
    }
    return it;
}
__device__ __forceinline__ CvItem cv_fox(const Args& a, unsigned char* ws, int j, int r) {
    CvItem it;
    if (r < 6144) { const int kb = r / 192, nb = r % 192, n0 = 32 * nb;
        it.src = GIN(a, 8) + (size_t)j * DMODEL * WIN_LD + (size_t)(64 * kb) * WIN_LD + n0; it.ldw = WIN_LD; it.gk = GIN(a, 5) + (size_t)(2 * j + 1) * DMODEL + 64 * kb;
        it.dst = (bf16*)(ws + WS_WFIN + (size_t)j * SZ_WFIN) + (size_t)n0 * DMODEL + 64 * kb; it.kd = DMODEL;
    } else { const int i = r - 6144, kb = i / 64, nb = i % 64, n0 = 32 * nb;
        it.src = GIN(a, 12) + (size_t)j * DMODEL * DMODEL + (size_t)(64 * kb) * DMODEL + n0; it.ldw = DMODEL; it.gk = nullptr;
        it.dst = (bf16*)(ws + WS_WFOUT + (size_t)j * SZ_WFOUT) + (size_t)n0 * DMODEL + 64 * kb; it.kd = DMODEL; }
    return it;
}
__device__ __forceinline__ CvItem cv_pool(const Args& a, unsigned char* ws, int j, int r) {
    const int jg = j * 4 + r / 128, i = r % 128, kb = i / 16, nb = i % 16, n0 = 32 * nb; CvItem it;
    it.src = GIN(a, 6) + (size_t)jg * 512 * 512 + (size_t)(64 * kb) * 512 + n0; it.ldw = 512; it.gk = GIN(a, 5) + (size_t)(2 * j) * DMODEL + (jg & 3) * 512 + 64 * kb;
    it.dst = (bf16*)(ws + WS_WPOOL) + (size_t)jg * 512 * 512 + (size_t)n0 * 512 + 64 * kb; it.kd = 512;
    return it;
}
__device__ __forceinline__ CvItem cv_decode(const Args& a, unsigned char* ws, int g) {
    if (g < CV_FFN) return cv_ffn(a, ws, 0, g);
    g -= CV_FFN; if (g < CV_POOL) return cv_pool(a, ws, 0, g);
    g -= CV_POOL; if (g < CV_FFN) return cv_ffn(a, ws, 1, g);
    g -= CV_FFN; if (g < CV_FOX) return cv_fox(a, ws, 0, g);
    g -= CV_FOX; if (g < 2 * CV_FFN) return cv_ffn(a, ws, 2 + g / CV_FFN, g % CV_FFN);
    g -= 2 * CV_FFN; if (g < CV_POOL) return cv_pool(a, ws, 1, g);
    g -= CV_POOL; if (g < 2 * CV_FFN) return cv_ffn(a, ws, 4 + g / CV_FFN, g % CV_FFN);
    g -= 2 * CV_FFN; if (g < CV_FOX) return cv_fox(a, ws, 1, g);
    g -= CV_FOX; return cv_ffn(a, ws, 6 + g / CV_FFN, g % CV_FFN);
}
__device__ __forceinline__ void cv_load(const CvItem& it, f32x4 (&v)[8], int lane) {
    asm volatile("" : "+v"(lane));
    const float* p = it.src + (size_t)(lane >> 3) * it.ldw + (lane & 7) * 4;
#pragma unroll
    for (int i = 0; i < 8; ++i) v[i] = __builtin_nontemporal_load((const f32x4*)(p + (size_t)(8 * i) * it.ldw));
}
__device__ __forceinline__ void cv_finish(const CvItem& it, const f32x4 (&v)[8], LAS float* scr, int lane) {
    asm volatile("" : "+v"(lane));
    const int kr = lane >> 3, n4 = (lane & 7) * 4;
#pragma unroll
    for (int i = 0; i < 8; ++i) *(LAS f32x4*)(scr + (8 * i + kr) * 32 + (n4 ^ (i << 2))) = v[i];
    const int c = lane & 7;
    f32x4 ga = {1.f, 1.f, 1.f, 1.f}, gb = {1.f, 1.f, 1.f, 1.f};
    if (it.gk) { ga = *(const f32x4*)(it.gk + 8 * c); gb = *(const f32x4*)(it.gk + 8 * c + 4); }
    LDS_WAIT(); asm volatile("" ::: "memory");
#pragma unroll
    for (int j = 0; j < 4; ++j) { const int n = (lane >> 3) + 8 * j; const LAS float* s = scr + (8 * c) * 32 + (n ^ (c << 2));
        v4u o; o.x = pg8::cvt_pk_bf16(s[0 * 32] * ga.x, s[1 * 32] * ga.y); o.y = pg8::cvt_pk_bf16(s[2 * 32] * ga.z, s[3 * 32] * ga.w); o.z = pg8::cvt_pk_bf16(s[4 * 32] * gb.x, s[5 * 32] * gb.y); o.w = pg8::cvt_pk_bf16(s[6 * 32] * gb.z, s[7 * 32] * gb.w);
        __builtin_nontemporal_store(o, (GAS v4u*)(it.dst + (size_t)n * it.kd + 8 * c)); }
    LDS_WAIT(); asm volatile("" ::: "memory");
}
__device__ __forceinline__ void cv_range(const Args& a, unsigned char* ws, int lo, int hi, int w, int nw, LAS float* scr, int lane) {
    int g = lo + 2 * w; if (g >= hi) return;
    const int step = 2 * nw;
    CvItem ia = cv_decode(a, ws, g), ib = cv_decode(a, ws, g + 1 < hi ? g + 1 : g), ja, jb;
    f32x4 va[8], vb[8], wa[8], wb[8];
    cv_load(ia, va, lane); cv_load(ib, vb, lane);
    for (;;) {
        const int g1 = g + step; const bool n1 = g1 < hi;
        if (n1) { ja = cv_decode(a, ws, g1); jb = cv_decode(a, ws, g1 + 1 < hi ? g1 + 1 : g1); cv_load(ja, wa, lane); cv_load(jb, wb, lane); }
        cv_finish(ia, va, scr, lane); if (g + 1 < hi) cv_finish(ib, vb, scr, lane);
        if (!n1) break;
        const int g2 = g1 + step; const bool n2 = g2 < hi;
        if (n2) { ia = cv_decode(a, ws, g2); ib = cv_decode(a, ws, g2 + 1 < hi ? g2 + 1 : g2); cv_load(ia, va, lane); cv_load(ib, vb, lane); }
        cv_finish(ja, wa, scr, lane); if (g1 + 1 < hi) cv_finish(jb, wb, scr, lane);
        if (!n2) break;
        g = g2;
    }
}
__device__ __forceinline__ void p_prologue(const Args& a, unsigned char* ws, Frame& F) {
    const int lane = opaque_tid() & 63;
    LAS float* scr = (LAS float*)(F.lds + RING_OFF + F.wave * 16384);
    const int gw = F.vcu * NWAVES + F.wave, NGW = F.G * NWAVES;
    cv_range(a, ws, 0, F.G == 256 ? CV_PRO : CV_TOTAL, gw, NGW, scr, lane);
    {
        float* wft = (float*)(ws + WS_WFT);
        for (int idx = gw * 64 + lane; idx < 2 * 16 * 2048; idx += NGW * 64) {
            const int j = idx >> 15, h = (idx >> 11) & 15, k = idx & 2047;
            wft[idx] = GIN(a, 8)[((size_t)j * DMODEL + k) * WIN_LD + NQKV + h] * GIN(a, 5)[(size_t)(2 * j + 1) * DMODEL + k];
        }
    }
    if (gw == 0) {
        float* gqk = (float*)(ws + WS_GQK);
        for (int idx = lane; idx < 512; idx += 64) { const int j = idx >> 8, w = (idx >> 7) & 1, d = idx & 127; gqk[idx] = w ? GIN(a, 11)[j * HDIM + d] : GIN(a, 10)[j * HDIM + d] * fox::QSCALE; }
        for (int j = 0; j < 2; ++j) {
            float aq = fmaxf(fabsf(GIN(a, 10)[j * HDIM + lane]), fabsf(GIN(a, 10)[j * HDIM + lane + 64])), ak = fmaxf(fabsf(GIN(a, 11)[j * HDIM + lane]), fabsf(GIN(a, 11)[j * HDIM + lane + 64]));
#pragma unroll
            for (int o = 32; o > 0; o >>= 1) { aq = fmaxf(aq, shfl_idx(aq, lane ^ o)); ak = fmaxf(ak, shfl_idx(ak, lane ^ o)); }
            if (lane == 0) gqk[512 + j] = 150.5f + 2.0f * (fox::LOG2E * 11.313708499f * 1.02f) * aq * ak;
        }
    }
    {
        bf16* XB = (bf16*)(ws + WS_XG); float* SSQ = (float*)(ws + WS_SSQ);
        for (int m = gw; m < M; m += NGW) {
            const GAS f32x4* xr = (const GAS f32x4*)(GIN(a, 0) + (size_t)m * DMODEL) + lane;
            f32x4 v[8]; float s = 0.f;
#pragma unroll
            for (int j = 0; j < 8; ++j) { v[j] = xr[64 * j]; s += (v[j].x * v[j].x + v[j].y * v[j].y) + (v[j].z * v[j].z + v[j].w * v[j].w); }
            s = wave_sum(s, lane);
            GAS u64_t* o8 = (GAS u64_t*)(XB + (size_t)m * DMODEL) + lane;
#pragma unroll
            for (int j = 0; j < 8; ++j) o8[64 * j] = (u64_t)pk2(v[j].x, v[j].y) | ((u64_t)pk2(v[j].z, v[j].w) << 32);
            if (lane < 32) SSQ[(size_t)m * 32 + lane] = lane == 0 ? s : 0.f;
        }
    }
}

template <int W, int NOUT> __device__ __forceinline__ void diff_rows(const bf16* colp, bf16* outp, const LAS float* rs_, int tb, int bs) {
    constexpr int NR = W - 1 + NOUT;
    bf16x8 raw[NR];
#pragma unroll
    for (int j = 0; j < NR; ++j) { const int r = tb - (W - 1) + j; raw[j] = (r >= bs) ? *(const bf16x8*)(colp + (size_t)r * DMODEL) : (bf16x8){0, 0, 0, 0, 0, 0, 0, 0}; }
    float s[8];
#pragma unroll
    for (int e = 0; e < 8; ++e) s[e] = 0.f;
#define HV(j, dst) do { const int r_ = tb - (W - 1) + (j); const float sc_ = (r_ >= bs) ? rs_[16 - (W - 1) + (j)] : 0.f; \
        _Pragma("unroll") for (int e_ = 0; e_ < 8; ++e_) dst[e_] = bf2f((unsigned short)raw[j][e_]) * sc_; } while (0)
#pragma unroll
    for (int j = 0; j < W - 1; ++j) { float h[8]; HV(j, h);
#pragma unroll
        for (int e = 0; e < 8; ++e) s[e] += h[e]; }
#pragma unroll
    for (int i = 0; i < NOUT; ++i) {
        const int t = tb + i; float h[8]; HV(i + W - 1, h);
#pragma unroll
        for (int e = 0; e < 8; ++e) s[e] += h[e];
        const int n = t - bs + 1; const float inv = 1.0f / (float)(n < W ? n : W);
        v4u o; o.x = pk2(s[0] * inv - h[0], s[1] * inv - h[1]); o.y = pk2(s[2] * inv - h[2], s[3] * inv - h[3]);
        o.z = pk2(s[4] * inv - h[4], s[5] * inv - h[5]); o.w = pk2(s[6] * inv - h[6], s[7] * inv - h[7]);
        *(GAS v4u*)(outp + (size_t)t * DMODEL) = o;
        float h2[8]; HV(i, h2);
#pragma unroll
        for (int e = 0; e < 8; ++e) s[e] -= h2[e];
    }
#undef HV
}
__device__ __forceinline__ void p_diff(const bf16* XG, const float* ssq, unsigned char* ws, Frame& F) {
    bf16* DIFF = (bf16*)(ws + WS_O);
    const int tid = opaque_tid();
    LAS float* rs = (LAS float*)(F.lds + RING_OFF);
    for (int v = F.vcu; v < M / 32; v += F.G) {
        const int r0 = 32 * v, bs = r0 & ~(SEQ - 1);
        if (tid < 48) {
            const int row = r0 - 16 + tid; float val = 0.f;
            if (row >= bs) { const f32x4* p = (const f32x4*)(ssq + (size_t)row * 32); float s = 0.f;
#pragma unroll
                for (int i = 0; i < 8; ++i) { const f32x4 q = p[i]; s += (q.x + q.y) + (q.z + q.w); }
                val = 1.0f / sqrtf(s * (1.0f / DMODEL) + 1e-6f); }
            rs[tid] = val;
        }
        __syncthreads();
        const int ch = tid & 255, half = tid >> 8, g = __builtin_amdgcn_readfirstlane(ch >> 6);
        const int tb = r0 + 16 * half;
        const bf16* colp = XG + ch * 8; bf16* outp = DIFF + ch * 8; const LAS float* rsb = rs + 16 * half;
#pragma unroll 1
        for (int hb = 0; hb < 2; ++hb) {
            const int t8 = tb + 8 * hb; const LAS float* r8 = rsb + 8 * hb;
            if (g == 0) diff_rows<2, 8>(colp, outp, r8, t8, bs); else if (g == 1) diff_rows<4, 8>(colp, outp, r8, t8, bs);
            else if (g == 2) diff_rows<8, 8>(colp, outp, r8, t8, bs); else diff_rows<16, 8>(colp, outp, r8, t8, bs);
        }
        __syncthreads();
    }
}

__device__ __forceinline__ void p_fgate(const Args& a, const bf16* x, const float* ssq, unsigned char* ws, Frame& F, int j) {
    const int lane = opaque_tid() & 63, rl = lane & 15, kq = lane >> 4;
    const int blk_l = F.wave >> 2, kw = F.wave & 3;
    const float* wft = (const float*)(ws + WS_WFT) + (size_t)j * 16 * 2048;
    const float* bfv = GIN(a, 9) + j * 16; float* LF = (float*)(ws + WS_LF);
    LAS float* part = (LAS float*)(F.lds + RING_OFF);
    for (int bp = F.vcu; bp < M / 32; bp += F.G) {
        const int r0 = bp * 32 + blk_l * 16;
        const bf16* xrow = x + (size_t)(r0 + rl) * DMODEL + kw * 512 + 8 * kq; const float* wrow = wft + (size_t)rl * DMODEL + kw * 512 + 8 * kq;
        f32x4 a0 = {0.f, 0.f, 0.f, 0.f}, a1 = a0, a2 = a0, a3 = a0;
#pragma unroll 8
        for (int kb = 0; kb < 16; ++kb) {
            const v4u xw = *(const v4u*)(xrow + 32 * kb);
            const f32x4 w0 = *(const f32x4*)(wrow + 32 * kb), w1 = *(const f32x4*)(wrow + 32 * kb + 4);
            a0 = __builtin_amdgcn_mfma_f32_16x16x4f32(pg8::bf_lo(xw.x), w0[0], a0, 0, 0, 0);
            a1 = __builtin_amdgcn_mfma_f32_16x16x4f32(pg8::bf_hi(xw.x), w0[1], a1, 0, 0, 0);
            a2 = __builtin_amdgcn_mfma_f32_16x16x4f32(pg8::bf_lo(xw.y), w0[2], a2, 0, 0, 0);
            a3 = __builtin_amdgcn_mfma_f32_16x16x4f32(pg8::bf_hi(xw.y), w0[3], a3, 0, 0, 0);
            a0 = __builtin_amdgcn_mfma_f32_16x16x4f32(pg8::bf_lo(xw.z), w1[0], a0, 0, 0, 0);
            a1 = __builtin_amdgcn_mfma_f32_16x16x4f32(pg8::bf_hi(xw.z), w1[1], a1, 0, 0, 0);
            a2 = __builtin_amdgcn_mfma_f32_16x16x4f32(pg8::bf_lo(xw.w), w1[2], a2, 0, 0, 0);
            a3 = __builtin_amdgcn_mfma_f32_16x16x4f32(pg8::bf_hi(xw.w), w1[3], a3, 0, 0, 0);
        }
        const float rs = pg8::row_rstd(ssq, r0 + rl, kq);
        *(LAS f32x4*)(part + (F.wave * 64 + lane) * 4) = (a0 + a1) + (a2 + a3);
        __syncthreads();
        {
            const LAS float* pp = part + (blk_l * 4 * 64 + lane) * 4 + kw;
            const float t = (pp[0] + pp[256]) + (pp[512] + pp[768]);
            const int ri = kq * 4 + kw; const float rsi = shfl_idx(rs, ri);
            const float fl = t * rsi + bfv[rl];
            const float lf = fminf(fl, 0.f) - 0.6931471805599453f * __builtin_amdgcn_logf(1.0f + __builtin_amdgcn_exp2f(-1.4426950408889634f * fabsf(fl)));
            const int row = r0 + ri, b = row >> 12, tt = row & (SEQ - 1);
            LF[((size_t)(b * NHEAD + rl)) * SEQ + tt] = lf;
        }
        __syncthreads();
    }
}

__device__ __forceinline__ void p_attn(unsigned char* ws, const float* thrp, const int vcu, const int rowpart, const int wave, char* lds) {
    const fox::bf16* Qb = (const fox::bf16*)(ws + WS_Q); const fox::bf16* Kb = (const fox::bf16*)(ws + WS_K); const fox::bf16* Vb = (const fox::bf16*)(ws + WS_V);
    fox::bf16* Ob = (fox::bf16*)(ws + WS_O); const float* LF = (const float*)(ws + WS_LF);
    const int it = rowpart ? ((((vcu >> 7) * 16 + (vcu & 15)) << 3) + 2 * ((vcu >> 5) & 3) + ((vcu >> 4) & 1)) : vcu, ltid = opaque_tid(), llane = ltid & 63;
    if (it < 256) {
        const int bh = it >> 3, s = it & 7, b = bh >> 4, h = bh & 15;
        {
            const f32x4* lf = (const f32x4*)(LF + (size_t)bh * SEQ) + 2 * ltid; const f32x4 x0 = lf[0], x1 = lf[1];
            float c[8]; c[0] = x0.x; c[1] = c[0] + x0.y; c[2] = c[1] + x0.z; c[3] = c[2] + x0.w; c[4] = c[3] + x1.x; c[5] = c[4] + x1.y; c[6] = c[5] + x1.z; c[7] = c[6] + x1.w;
            float inc = c[7];
#pragma unroll
            for (int o = 1; o < 64; o <<= 1) { const float n = shfl_idx(inc, llane - o); if (llane >= o) inc += n; }
            float* wsum = (float*)(lds + fox::LDS_WS);
            if (llane == 63) wsum[wave] = inc;
            __syncthreads();
            float off = inc - c[7];
            for (int w = 0; w < wave; ++w) off += wsum[w];
            float* Fl = (float*)(lds + fox::LDS_F) + 8 * ltid;
            *(f32x4*)Fl = (f32x4){(off + c[0]) * fox::LOG2E, (off + c[1]) * fox::LOG2E, (off + c[2]) * fox::LOG2E, (off + c[3]) * fox::LOG2E};
            *(f32x4*)(Fl + 4) = (f32x4){(off + c[4]) * fox::LOG2E, (off + c[5]) * fox::LOG2E, (off + c[6]) * fox::LOG2E, (off + c[7]) * fox::LOG2E};
            __syncthreads();
        }
#define FOX_REF(qb, jlo_) fox::BlockRef{Qb + ((size_t)bh * SEQ + (size_t)(qb) * fox::QB) * HDIM, Kb + (size_t)bh * SEQ * HDIM, Vb + (size_t)bh * SEQ * HDIM, \
                                  Ob + ((size_t)b * SEQ + (size_t)(qb) * fox::QB) * DMODEL + h * HDIM, (qb) * fox::QB, (jlo_), FOX_SKIP ? thr : -1.f}
#if FOX_SKIP
        const float thr = thrp[0];
        const float* Fa = (const float*)(lds + fox::LDS_F);
#define FOX_JLO(P0_) __builtin_amdgcn_readfirstlane((int)__builtin_ctzll(~__ballot((64 * llane + 63 < (P0_)) && (Fa[(P0_)] - Fa[64 * llane + 63] <= -thr))))
#else
#define FOX_JLO(P0_) 0
#endif
        const int qb0 = FOX_SKIP ? 2 * s : s, qb1 = FOX_SKIP ? 2 * s + 1 : 15 - s;
        const int jlo0 = FOX_JLO(qb0 * fox::QB), jlo1 = FOX_JLO(qb1 * fox::QB);
        fox::BlockRef cur = FOX_REF(qb0, jlo0);
        fox::Seam S;
        fox::fox_prime(cur, lds, S);
        for (int pass = 0; pass < 2; ++pass) {
            const fox::BlockRef nxt = (pass == 0) ? FOX_REF(qb1, jlo1) : cur;
            fox::fox_block(cur, nxt, lds, S);
            cur = nxt;
        }
#undef FOX_REF
#undef FOX_JLO
    }
}

__global__ void __launch_bounds__(NWAVES * 64, 2) mega_fwd(Args args) {
    extern __shared__ __attribute__((aligned(16))) unsigned char lds[];
    Frame F;
    F.lds = (LAS unsigned char*)lds;
    F.MISC = (volatile LAS unsigned*)(F.lds + MISC_OFF);
    F.tid = threadIdx.x; F.lane = F.tid & 63; F.wave = __builtin_amdgcn_readfirstlane(F.tid >> 6);
    F.G = gridDim.x; { const int bx = blockIdx.x; F.vcu = (F.G % 8 == 0) ? (bx % 8) * (F.G / 8) + bx / 8 : bx; }
    unsigned char* const ws0 = args.ws;
    F.ctl = (gu32*)(ws0 + WS_CTL);
    for (int u = F.tid; u < (LDS_BYTES - LDSCTL_OFF) / 4; u += NWAVES * 64) ((LAS unsigned*)(F.lds + LDSCTL_OFF))[u] = 0u;
    __syncthreads();
    XcdBarrier bar; bar.bar = (unsigned*)(F.ctl + CW_BAR); bar.x = 0; bar.st = nullptr;
    if (!MK_MULTI) bar = xcd_barrier_post((unsigned*)(F.ctl + CW_BAR), F.MISC + 8);

    const int lo = args.ph_lo, hi = args.ph_hi; int pc = 0;
#if PROBE_CLASS >= 0
    unsigned long long pr_prev = rt(), pr_acc = 0;
#if PROBE_CLASS == 10
    unsigned long long pc_prev = __builtin_amdgcn_s_memtime();
#define PH_STAMP(cls) do { const unsigned long long pc_now = __builtin_amdgcn_s_memtime(); if ((cls) == 1) pr_acc += (pc_now - pc_prev) / 20ull; pc_prev = pc_now; } while (0)
#else
#define PH_STAMP(cls) do { const unsigned long long pr_now = rt(); if ((cls) == PROBE_CLASS) pr_acc += (pr_now - pr_prev) * PROBE_AMP; pr_prev = pr_now; } while (0)
#endif
#else
#define PH_STAMP(cls) do { } while (0)
#endif
#define PH_BEGIN if (pc >= lo && pc < hi) { unsigned long long wsu_ = (unsigned long long)ws0; \
    Frame P = F; P.G = __builtin_amdgcn_readfirstlane(F.G); P.vcu = __builtin_amdgcn_readfirstlane(F.vcu); P.wave = __builtin_amdgcn_readfirstlane(F.wave); P.rowpart = __builtin_amdgcn_readfirstlane(F.rowpart); \
    int bx = P.rowpart ? P.vcu : __builtin_amdgcn_readfirstlane((int)blockIdx.x);     \
    asm volatile("" : "+s"(wsu_), "+s"(P.G), "+s"(P.vcu), "+s"(P.wave), "+s"(bx), "+s"(P.rowpart)); unsigned char* ws = (unsigned char*)(GAS unsigned char*)wsu_; \
    bf16* const XG = (bf16*)(ws + (xsel ? WS_XG2 : WS_XG)); bf16* const HACT = (bf16*)(ws + WS_HACT); float* const SSQ = (float*)(ws + (xsel ? WS_SSQ2 : WS_SSQ)); (void)XG; (void)HACT; (void)SSQ;
#define PH_FINISH(cls, glob)   PH_STAMP(cls); if (pc + 1 < hi) { if ((glob) || !P.rowpart) xcd_barrier(bar); else xcd_local_barrier(bar); } PH_STAMP(((glob) || !P.rowpart) ? 12 : 11); } ++pc;

    F.rowpart = 0;
    int xsel = 0;
    PH_BEGIN p_prologue(args, ws, P); PH_FINISH(0, true)
    if (!MK_MULTI) { const unsigned ev = F.MISC[10], rk = F.MISC[11];
        if (__builtin_amdgcn_readfirstlane(ev) == 1u) { F.rowpart = 1; F.vcu = (int)bar.x * 32 + (int)__builtin_amdgcn_readfirstlane(rk); } }

    for (int s = 0; s < 8; ++s) {
        const int L = s >> 1, f = s & 1;
        xsel = (s >= 1 && s <= 4) ? 1 : 0;
        PH_BEGIN
            pg8::Gemm g{XG, (const bf16*)(ws + WS_WGU + (size_t)s * SZ_WGU), M, NGU, DMODEL, DMODEL, 30, 0};
            pg8::StaticOrder S; S.init(M, NGU, P.G, bx, P.rowpart);
            pg8::EpiSwiglu E{HACT, DFF, (LAS float*)(P.lds + RTAB_OFF), SSQ};
            pg8::gemm_phase<pg8::EpiSwiglu, pg8::StaticOrder, true, true>(P.lds + RING_OFF, g, S, E);
            const bool five = P.rowpart ? (bx & 31) >= 16 : bx >= 128;
            if (P.G == 256 && five && s < 7) {
                static_assert(CV_PRO + 7 * CV_TAIL == CV_TOTAL && CV_PRO >= 2 * CV_FFN + CV_POOL, "conversion shares");
                static_assert(cv_seams_ok(), "a grid barrier must lie between every conversion share and its first reader");
                const int lo_ = CV_PRO + s * CV_TAIL, hi_ = lo_ + CV_TAIL;
                const int cw = P.rowpart ? (bx >> 5) * 16 + (bx & 31) - 16 : bx - 128;
                cv_range(args, ws, lo_, hi_, cw * NWAVES + P.wave, 128 * NWAVES, (LAS float*)(P.lds + RING_OFF + P.wave * 16384), opaque_tid() & 63);
            }
        PH_FINISH(1, false)
        PH_BEGIN
            pg8::Gemm g{HACT, (const bf16*)(ws + WS_WD + (size_t)s * SZ_WD), M, DMODEL, DFF, DFF, 30, 0};
            pg8::StaticOrder S; S.init(M, DMODEL, P.G, bx, P.rowpart);
            pg8::EpiResid<true, false> E{XG, XG, s == 7 ? (float*)(GAS float*)args.out : nullptr, nullptr, SSQ};
            pg8::gemm_phase<pg8::EpiResid<true, false>, pg8::StaticOrder, true, true>(P.lds + RING_OFF, g, S, E);
        PH_FINISH(2, (f == 0 && (L & 1) == 0) || s == 5)
        if (f == 0) {
            const int j = L >> 1;
            if ((L & 1) == 0) {
                PH_BEGIN p_diff(XG, SSQ, ws, P); PH_FINISH(3, false)
                PH_BEGIN
                    pg8::Gemm g{(const bf16*)(ws + WS_O), (const bf16*)(ws + WS_WPOOL + (size_t)j * SZ_WPOOL), M, DMODEL, 512, DMODEL, 1, 1024};
                    pg8::StaticOrder S; S.init(M, DMODEL, P.G, bx, P.rowpart);
                    pg8::EpiResid<false, true> E{XG, (bf16*)(ws + (xsel ? WS_XG : WS_XG2)), nullptr, GIN(args, 7) + (size_t)j * DMODEL, (float*)(ws + (xsel ? WS_SSQ : WS_SSQ2))};
                    pg8::gemm_phase<pg8::EpiResid<false, true>, pg8::StaticOrder, true, true>(P.lds + RING_OFF, g, S, E);
                PH_FINISH(4, false)
            } else {
                PH_BEGIN
                    pg8::Gemm g{XG, (const bf16*)(ws + WS_WFIN + (size_t)j * SZ_WFIN), M, NQKV, DMODEL, DMODEL, 30, 0};
                    pg8::StaticOrder S; S.init(M, NQKV, P.G, bx, P.rowpart);
                    p_fgate(args, XG, SSQ, ws, P, j); PH_STAMP(9);
                    pg8::EpiQKV E{(bf16*)(ws + WS_Q), (size_t)M * DMODEL, (LAS float*)(P.lds + RTAB_OFF), (const float*)(ws + WS_GQK) + j * 256, (LAS float*)(P.lds + XCH_OFF), SSQ};
                    pg8::gemm_phase<pg8::EpiQKV, pg8::StaticOrder, true, true>(P.lds + RING_OFF, g, S, E);
                PH_FINISH(5, true)
                PH_BEGIN p_attn(ws, (const float*)(ws + WS_GQK) + 512 + j, P.vcu, P.rowpart, P.wave, (char*)lds + RING_OFF); PH_FINISH(7, false)
                PH_BEGIN
                    pg8::Gemm g{(const bf16*)(ws + WS_O), (const bf16*)(ws + WS_WFOUT + (size_t)j * SZ_WFOUT), M, DMODEL, DMODEL, DMODEL, 30, 0};
                    pg8::StaticOrder S; S.init(M, DMODEL, P.G, bx, P.rowpart);
                    pg8::EpiResid<false, false> E{XG, XG, nullptr, nullptr, SSQ};
                    pg8::gemm_phase<pg8::EpiResid<false, false>, pg8::StaticOrder, true, true>(P.lds + RING_OFF, g, S, E);
                PH_FINISH(8, false)
            }
        }
    }
#undef PH_BEGIN
#undef PH_FINISH
#if PROBE_CLASS >= 0
    if (blockIdx.x == 0 && F.tid == 0) { const unsigned long long t0 = rt(); while (rt() - t0 < pr_acc) __builtin_amdgcn_s_sleep(16); }
#endif
}

extern "C" void kernel_launch(void* const* d_in, const int* in_sizes, int n_in, void* d_out, int out_size, void* d_ws, size_t ws_size, hipStream_t stream) {
    static int grid = 0;
    if (grid == 0) {
        if (n_in != 17 || in_sizes[0] != M * DMODEL || out_size != M * DMODEL || ws_size < WS_END) {
            fprintf(stderr, "kernel_launch: built for 17 inputs, x and out of %d floats, >= %zu bytes of workspace; got n_in %d, in0 %d, out %d, ws %zu; nothing launched\n", M * DMODEL, (size_t)WS_END, n_in, n_in > 0 ? in_sizes[0] : -1, out_size, ws_size);
            grid = -1; return; }
        int dev = 0, cus = 0, per_cu = 0;
        if (hipGetDevice(&dev) != hipSuccess || hipDeviceGetAttribute(&cus, hipDeviceAttributeMultiprocessorCount, dev) != hipSuccess) { fprintf(stderr, "kernel_launch: device query failed\n"); grid = -1; return; }
        if (hipFuncSetAttribute((const void*)mega_fwd, hipFuncAttributeMaxDynamicSharedMemorySize, LDS_BYTES) != hipSuccess) { fprintf(stderr, "kernel_launch: hipFuncSetAttribute failed\n"); grid = -1; return; }
        if (hipOccupancyMaxActiveBlocksPerMultiprocessor(&per_cu, (const void*)mega_fwd, NWAVES * 64, LDS_BYTES) != hipSuccess || per_cu < 1)
            fprintf(stderr, "kernel_launch: note: occupancy query reports %d workgroups per CU\n", per_cu);
        (void)hipGetLastError();
        grid = cus;
    }
    if (grid < 0) return;
    if (hipMemsetAsync((char*)d_ws + WS_CTL, 0, CTL_ZERO_BYTES, stream) != hipSuccess) { fprintf(stderr, "kernel_launch: memset failed\n"); return; }
    Args a{};
    for (int i = 0; i < 17; ++i) a.in[i] = (const float*)d_in[i];
    a.out = (float*)d_out; a.ws = (unsigned char*)d_ws;
#if MK_MULTI
    for (int p = 0; p < N_PHASES; ++p) { a.ph_lo = p; a.ph_hi = p + 1; hipLaunchKernelGGL(mega_fwd, dim3(grid), dim3(NWAVES * 64), LDS_BYTES, stream, a); }
#else
    a.ph_lo = 0; a.ph_hi = N_PHASES;
    hipLaunchKernelGGL(mega_fwd, dim3(grid), dim3(NWAVES * 64), LDS_BYTES, stream, a);
#endif
    const hipError_t le = hipPeekAtLastError();
    if (le != hipSuccess) fprintf(stderr, "kernel_launch: launch failed: %s\n", hipGetErrorName(le));
}
```

```cpp
#include <hip/hip_runtime.h>
#include <hip/hip_bf16.h>
#include <cstdio>
#include <cstdint>

__device__ __forceinline__ int opaque_tid() { int t = (int)threadIdx.x; asm volatile("" : "+v"(t)); return t; }
__device__ __forceinline__ float xsum16(float v) { const auto r = __builtin_amdgcn_permlane16_swap(__float_as_uint(v), __float_as_uint(v), false, false); return __uint_as_float(r[0]) + __uint_as_float(r[1]); }
__device__ __forceinline__ float xsum32(float v) { const auto r = __builtin_amdgcn_permlane32_swap(__float_as_uint(v), __float_as_uint(v), false, false); return __uint_as_float(r[0]) + __uint_as_float(r[1]); }

__device__ __forceinline__ float shfl_idx(float v, int src) { return __builtin_bit_cast(float, __builtin_amdgcn_ds_bpermute(src << 2, __builtin_bit_cast(int, v))); }

namespace pg8 {
#define PG8_LAS __attribute__((address_space(3)))
typedef unsigned short bf16_t;
typedef short bf16x8 __attribute__((ext_vector_type(8)));
typedef float f32x4 __attribute__((ext_vector_type(4)));
typedef unsigned u32x4 __attribute__((ext_vector_type(4)));
typedef unsigned u32x2 __attribute__((ext_vector_type(2)));
constexpr int BM = 256, BK = 64, HALF = 128, HTB = HALF * BK * 2  , STAGE_BYTES = 8 * HTB, NXCD = 8, WGM = 8;

__host__ __device__ __forceinline__ int lds_byte(int r, int c) { const int st = (r >> 4) * 2 + (c >> 5), rr = r & 15, cc = c & 31, ob = rr * 64 + cc * 2; return st * 1024 + (ob ^ (((ob >> 9) & 1) << 5)); }
__host__ __device__ __forceinline__ void stage_rc(int b, int& R, int& C) { const int st = b / 1024, sb = b % 1024, swz = sb ^ (((sb >> 9) & 1) << 5); R = (st >> 1) * 16 + swz / 64; C = (st & 1) * 32 + (swz % 64) / 2; }
__host__ __device__ __forceinline__ int perm32(int rho) { const int n = rho >> 4, i = rho & 15; return 8 * (i >> 2) + 4 * n + (i & 3); }

struct Unit { int pm, pn, idx; };
struct Gemm { const bf16_t* A; const bf16_t* Bt; int M, N, K; int lda; int a_shift; int a_gbytes; };

struct StaticOrder {
    int nM, nN, nwg, G, c, i0, i1, rowpart;
    __host__ __device__ void init(int M, int N, int G_, int c_, int rowpart_ = 0) { nM = M / BM; nN = N / BM; nwg = nM * nN; G = G_; c = c_; i0 = 0; i1 = 1 << 30; rowpart = rowpart_; }
    __host__ __device__ bool next(int i, Unit& u) const {
        if (i + i0 >= i1) return false;
        if (rowpart) { const int rp = nM >> 3, q = (i + i0) * 32 + (c & 31); if (q >= rp * nN) return false;
            u.pm = (c >> 5) * rp + q % rp; u.pn = q / rp; u.idx = i + i0; return true; }
        const long L = (long)(i + i0) * G + c; if (L >= nwg) return false;
        int wgid = (int)L; { const int q = nwg / NXCD, r = nwg % NXCD, xcd = wgid % NXCD, off = wgid / NXCD; wgid = (xcd < r ? xcd * (q + 1) : r * (q + 1) + (xcd - r) * q) + off; }
        const int nig = WGM * nN, gid = wgid / nig, fm = gid * WGM, gsz = (nM - fm) < WGM ? (nM - fm) : WGM;
        u.pm = fm + ((wgid % nig) % gsz); u.pn = (wgid % nig) / gsz; u.idx = i + i0; return true;
    }
    __device__ __forceinline__ void a_ready(const Unit&) const {}
    __device__ __forceinline__ void done(const Unit&) const {}
};

__device__ __forceinline__ unsigned cvt_pk_bf16(float lo, float hi) { unsigned r; asm volatile("v_cvt_pk_bf16_f32 %0, %1, %2" : "=v"(r) : "v"(lo), "v"(hi)); return r; }

constexpr int DM = 2048;
constexpr int SSQ_PARTS = 32;
constexpr float RMS_EPS = 1e-6f;
__device__ __forceinline__ float row_rstd(const float* ssq, int row, int fq) {
    const f32x4* p = (const f32x4*)(ssq + (size_t)row * SSQ_PARTS + fq * 8);
    const f32x4 a = p[0], b = p[1];
    float s = ((a[0] + a[1]) + (a[2] + a[3])) + ((b[0] + b[1]) + (b[2] + b[3]));
    s = xsum32(xsum16(s));
    return __builtin_amdgcn_rsqf(s * (1.0f / DM) + RMS_EPS);
}

__device__ __forceinline__ void row_rstd8(const float* ssq, int row0, int fq, float (&rs)[2][4]) {
#pragma unroll
    for (int ai = 0; ai < 2; ++ai) {
        f32x4 pa[4], pb[4];
#pragma unroll
        for (int m = 0; m < 4; ++m) { const f32x4* p = (const f32x4*)(ssq + (size_t)(row0 + ai * HALF + m * 16) * SSQ_PARTS + fq * 8); pa[m] = p[0]; pb[m] = p[1]; }
#pragma unroll
        for (int m = 0; m < 4; ++m) { const f32x4 a = pa[m], b = pb[m];
            float s = ((a[0] + a[1]) + (a[2] + a[3])) + ((b[0] + b[1]) + (b[2] + b[3]));
            s = xsum32(xsum16(s));
            rs[ai][m] = __builtin_amdgcn_rsqf(s * (1.0f / DM) + RMS_EPS); }
        asm volatile("" ::: "memory");
    }
}

template <bool SYNC, class Sched> __device__ __forceinline__ void rstd_table(const float* ssq, const Sched& S, PG8_LAS float* rtab, int max_rounds, int tid) {
    for (int idx = tid; idx < max_rounds * BM; idx += 512) {
        Unit u; if (!S.next(idx >> 8, u)) break;
        const f32x4* p = (const f32x4*)(ssq + (size_t)(u.pm * BM + (idx & 255)) * SSQ_PARTS);
        float s = 0.f;
#pragma unroll
        for (int i = 0; i < 8; ++i) { const f32x4 q = p[i]; s += (q[0] + q[1]) + (q[2] + q[3]); }
        rtab[idx] = __builtin_amdgcn_rsqf(s * (1.0f / DM) + RMS_EPS);
    }
    if constexpr (SYNC) { asm volatile("s_waitcnt lgkmcnt(0)" ::: "memory"); __syncthreads(); }
}

struct EpiSwiglu {
    static constexpr bool PERM = true, AFTER_DRAIN = false;
    bf16_t* H; int ldh; PG8_LAS float* rtab; const float* ssq;
    template <class Sched> __device__ __forceinline__ void after_issue(const Sched& S, int tid) const { rstd_table<false>(ssq, S, rtab, 6, tid); }
    __device__ __forceinline__ void operator()(const f32x4 (&acc)[2][2][4][2], const Unit& u, int wr, int wc, int fr, int fq) const {
        const int row0 = u.pm * BM + wr * 64 + fr, col0 = u.pn * HALF + wc * 32 + 8 * fq;
#pragma unroll
        for (int ai = 0; ai < 2; ++ai)
#pragma unroll
            for (int m = 0; m < 4; ++m) {
                const int row = row0 + ai * HALF + m * 16;
                const float rs = rtab[u.idx * BM + wr * 64 + fr + ai * HALF + m * 16];
                const float rs2 = rs * -1.4426950408889634f, irs = __builtin_amdgcn_rcpf(rs * rs);
                float o[8];
#pragma unroll
                for (int n = 0; n < 2; ++n)
#pragma unroll
                    for (int j = 0; j < 4; ++j) {
                        const float ag = acc[ai][0][m][n][j], au = acc[ai][1][m][n][j];
                        const float e = __builtin_amdgcn_exp2f(ag * rs2);
                        o[n * 4 + j] = (ag * au) * __builtin_amdgcn_rcpf(__builtin_fmaf(e, irs, irs));
                    }
                u32x4 w; w.x = cvt_pk_bf16(o[0], o[1]); w.y = cvt_pk_bf16(o[2], o[3]); w.z = cvt_pk_bf16(o[4], o[5]); w.w = cvt_pk_bf16(o[6], o[7]);
                *(u32x4*)(H + (size_t)row * ldh + col0) = w;
            }
    }
};

__device__ __forceinline__ float bf_lo(unsigned w) { return __builtin_bit_cast(float, w << 16); }
__device__ __forceinline__ float bf_hi(unsigned w) { return __builtin_bit_cast(float, w & 0xffff0000u); }
template <bool HALFSTEP  , bool HASVEC  > struct EpiResid {
    static constexpr bool PERM = true, AFTER_DRAIN = false;
    const bf16_t* xb; bf16_t* xo; float* xf; const float* cvec; float* ssq;
    template <class Sched> __device__ __forceinline__ void after_issue(const Sched&, int) const {}
    __device__ __forceinline__ void operator()(const f32x4 (&acc)[2][2][4][2], const Unit& u, int wr, int wc, int fr, int fq) const {
        const int row0 = u.pm * BM + wr * 64 + fr, col0 = u.pn * BM + wc * 32 + 8 * fq;
        constexpr float cs = HALFSTEP ? 0.5f : 1.0f;
        f32x4 cv[2][2];
#pragma unroll
        for (int bj = 0; bj < 2; ++bj)
#pragma unroll
            for (int n = 0; n < 2; ++n) cv[bj][n] = HASVEC ? *(const f32x4*)(cvec + col0 + bj * HALF + 4 * n) * cs : (f32x4){cs, cs, cs, cs};
        u32x4 xr[2][4][2];
#define EPR_LOAD(ai) do { _Pragma("unroll") for (int m = 0; m < 4; ++m) _Pragma("unroll") for (int bj = 0; bj < 2; ++bj) \
            xr[ai][m][bj] = *(const u32x4*)(xb + (size_t)(row0 + (ai) * HALF + m * 16) * DM + col0 + bj * HALF); } while (0)
        EPR_LOAD(0);
        asm volatile("" ::: "memory");
#pragma unroll
        for (int ai = 0; ai < 2; ++ai)
#pragma unroll
            for (int m = 0; m < 4; ++m) {
                if (ai == 0 && m == (HASVEC ? 2 : 0)) { EPR_LOAD(1); asm volatile("" ::: "memory"); }
                const int row = row0 + ai * HALF + m * 16;
                float sq = 0.f;
#pragma unroll
                for (int bj = 0; bj < 2; ++bj) {
                    const u32x4 w = xr[ai][m][bj];
                    const f32x4 x0 = {bf_lo(w.x), bf_hi(w.x), bf_lo(w.y), bf_hi(w.y)}, x1 = {bf_lo(w.z), bf_hi(w.z), bf_lo(w.w), bf_hi(w.w)};
                    const f32x4 n0 = x0 + acc[ai][bj][m][0] * cv[bj][0], n1 = x1 + acc[ai][bj][m][1] * cv[bj][1];
                    sq += ((n0[0] * n0[0] + n0[1] * n0[1]) + (n0[2] * n0[2] + n0[3] * n0[3])) + ((n1[0] * n1[0] + n1[1] * n1[1]) + (n1[2] * n1[2] + n1[3] * n1[3]));
                    const size_t off = (size_t)row * DM + col0 + bj * HALF;
                    if (xf) { *(f32x4*)(xf + off) = n0; *(f32x4*)(xf + off + 4) = n1; }
                    else { u32x4 o; o.x = cvt_pk_bf16(n0[0], n0[1]); o.y = cvt_pk_bf16(n0[2], n0[3]); o.z = cvt_pk_bf16(n1[0], n1[1]); o.w = cvt_pk_bf16(n1[2], n1[3]); *(u32x4*)(xo + off) = o; }
                }
                sq = xsum32(xsum16(sq));
                if (!xf && fq == 0) ssq[(size_t)row * SSQ_PARTS + u.pn * 4 + wc] = sq;
            }
#undef EPR_LOAD
    }
};

struct EpiQKV {
    static constexpr bool PERM = true, AFTER_DRAIN = false;
    bf16_t* Q; size_t tstride; PG8_LAS float* rtab; const float* gqk; PG8_LAS float* xch; const float* ssq;
    template <class Sched> __device__ __forceinline__ void after_issue(const Sched& S, int tid) const { rstd_table<false>(ssq, S, rtab, 3, tid); }
    __device__ __forceinline__ void operator()(const f32x4 (&acc)[2][2][4][2], const Unit& u, int wr, int wc, int fr, int fq) const {
        const int which = u.pn >> 3, hp = u.pn & 7;
        bf16_t* base = Q + (size_t)which * tstride;
        const int row0 = u.pm * BM + wr * 64 + fr, d0 = wc * 32 + 8 * fq, rl0 = wr * 64 + fr;
        float rs[2][4], hs[2][4][2];
#pragma unroll
        for (int ai = 0; ai < 2; ++ai)
#pragma unroll
            for (int m = 0; m < 4; ++m) { rs[ai][m] = rtab[u.idx * BM + rl0 + ai * HALF + m * 16]; hs[ai][m][0] = 1.f; hs[ai][m][1] = 1.f; }
        f32x4 g0 = {1.f, 1.f, 1.f, 1.f}, g1 = {1.f, 1.f, 1.f, 1.f};
        if (which < 2) {
            g0 = *(const f32x4*)(gqk + which * 128 + d0); g1 = *(const f32x4*)(gqk + which * 128 + d0 + 4);
#pragma unroll
            for (int ai = 0; ai < 2; ++ai)
#pragma unroll
                for (int m = 0; m < 4; ++m)
#pragma unroll
                    for (int bj = 0; bj < 2; ++bj) {
                        const f32x4 v0 = acc[ai][bj][m][0], v1 = acc[ai][bj][m][1];
                        float p = ((v0[0] * v0[0] + v0[1] * v0[1]) + (v0[2] * v0[2] + v0[3] * v0[3])) + ((v1[0] * v1[0] + v1[1] * v1[1]) + (v1[2] * v1[2] + v1[3] * v1[3]));
                        p *= rs[ai][m] * rs[ai][m];
                        p = xsum32(xsum16(p));
                        if (fq == 0) xch[((ai * HALF + rl0 + m * 16) * 2 + bj) * 4 + wc] = p;
                    }
            asm volatile("s_waitcnt lgkmcnt(0)" ::: "memory"); __builtin_amdgcn_s_barrier(); asm volatile("" ::: "memory");
#pragma unroll
            for (int ai = 0; ai < 2; ++ai)
#pragma unroll
                for (int m = 0; m < 4; ++m)
#pragma unroll
                    for (int bj = 0; bj < 2; ++bj) {
                        const f32x4 t = *(const PG8_LAS f32x4*)(xch + ((ai * HALF + rl0 + m * 16) * 2 + bj) * 4);
                        hs[ai][m][bj] = __builtin_amdgcn_rsqf(((t[0] + t[1]) + (t[2] + t[3])) * (1.0f / 128.0f) + RMS_EPS);
                    }
        }
#pragma unroll
        for (int ai = 0; ai < 2; ++ai)
#pragma unroll
            for (int m = 0; m < 4; ++m) {
                const int row = row0 + ai * HALF + m * 16;
                const int b = row >> 12, t = row & 4095;
#pragma unroll
                for (int bj = 0; bj < 2; ++bj) {
                    const int h = 2 * hp + bj;
                    const float sc = rs[ai][m] * hs[ai][m][bj];
                    const f32x4 v0 = acc[ai][bj][m][0] * sc * g0, v1 = acc[ai][bj][m][1] * sc * g1;
                    u32x4 w; w.x = cvt_pk_bf16(v0[0], v0[1]); w.y = cvt_pk_bf16(v0[2], v0[3]); w.z = cvt_pk_bf16(v1[0], v1[1]); w.w = cvt_pk_bf16(v1[2], v1[3]);
                    *(u32x4*)(base + (((size_t)(b * 16 + h) * 4096 + t) * 128 + d0)) = w;
                }
            }
    }
};

template <class Epi, class Sched, bool ALIGN_EPI = false, bool SP2 = false, class Seam>
__device__ __forceinline__ void gemm_phase(PG8_LAS unsigned char* lds, const Gemm g, const Sched& S, const Epi& E, const Seam& seam) {
    const int tid = opaque_tid(), wid = __builtin_amdgcn_readfirstlane(tid >> 6), lane = tid & 63, wr = wid >> 2, wc = wid & 3, fr = lane & 15, fq = lane >> 4;
    const int K = g.K, nt = K / BK;
    unsigned voffA[2], voffB[2];
#pragma unroll
    for (int i = 0; i < 2; ++i) { int R, C; stage_rc(tid * 16 + i * 8192, R, C); const int Rb = Epi::PERM ? ((R & ~31) + perm32(R & 31)) : R;
        voffA[i] = (unsigned)(R * g.lda + C) * 2u; voffB[i] = (unsigned)(Rb * K + C) * 2u; }
    const unsigned kstep = (unsigned)(BK * 2);
    const unsigned hstepA = (unsigned)HALF * g.lda * 2, hstepB = (unsigned)HALF * K * 2;
    const unsigned tstepA = 2 * hstepA, tstepB = 2 * hstepB;
#define PG8_AOFF(u) ((unsigned)(u).pm * tstepA + (unsigned)((u).pn >> g.a_shift) * (unsigned)g.a_gbytes)
    const __amdgpu_buffer_rsrc_t rsrcA = __builtin_amdgcn_make_buffer_rsrc((void*)g.A, 0, 0x7fffffff, 0x00020000), rsrcB = __builtin_amdgcn_make_buffer_rsrc((void*)g.Bt, 0, 0x7fffffff, 0x00020000);
    const unsigned ldsw = (unsigned)wid * 1024u;
    const int aoff = lds_byte(wr * 64 + fr, fq * 8), boff = lds_byte(wc * 32 + fr, fq * 8);
#define PG8_SA(b, h) (((b) * 2 + (h)) * HTB)
#define PG8_SB(b, h) ((4 + (b) * 2 + (h)) * HTB)
#ifndef PG8_AUX_A
#define PG8_AUX_A 0
#endif
#ifndef PG8_AUX_B
#define PG8_AUX_B 0
#endif
#define PG8_STAGE_X(bufoff, soff, voff, aux, rsrc) do { _Pragma("unroll") for (int _i = 0; _i < 2; ++_i) \
        __builtin_amdgcn_raw_ptr_buffer_load_lds(rsrc, (PG8_LAS unsigned*)(lds + (bufoff) + ldsw + _i * 8192), 16, (int)(voff)[_i], (int)(soff), 0, aux); } while (0)
#define PG8_STAGE_A(bufoff, soff, voff) PG8_STAGE_X(bufoff, soff, voff, PG8_AUX_A, rsrcA)
#define PG8_STAGE_B(bufoff, soff, voff) PG8_STAGE_X(bufoff, soff, voff, PG8_AUX_B, rsrcB)
#define PG8_LDA(dst, b, h) do { _Pragma("unroll") for (int m = 0; m < 4; ++m) _Pragma("unroll") for (int k = 0; k < 2; ++k) dst[m][k] = *(const PG8_LAS bf16x8*)(lds + PG8_SA(b, h) + aoff + m * 2048 + k * 1024); } while (0)
#define PG8_LDB(dst, b, h) do { _Pragma("unroll") for (int n = 0; n < 2; ++n) _Pragma("unroll") for (int k = 0; k < 2; ++k) dst[n][k] = *(const PG8_LAS bf16x8*)(lds + PG8_SB(b, h) + boff + n * 2048 + k * 1024); } while (0)
#define PG8_MMA(ai, bj, At, Bt) do { __builtin_amdgcn_s_setprio(1); _Pragma("unroll") for (int m = 0; m < 4; ++m) _Pragma("unroll") for (int n = 0; n < 2; ++n) _Pragma("unroll") for (int k = 0; k < 2; ++k) \
        acc[ai][bj][m][n] = __builtin_amdgcn_mfma_f32_16x16x32_bf16(Bt[n][k], At[m][k], acc[ai][bj][m][n], 0, 0, 0); __builtin_amdgcn_s_setprio(0); } while (0)
#define PG8_WAIT_V(n) asm volatile("s_waitcnt vmcnt(" #n ")" ::: "memory")
#define PG8_WAIT_L(n) asm volatile("s_waitcnt lgkmcnt(" #n ")" ::: "memory")
#define PG8_BAR __builtin_amdgcn_s_barrier()
#define PG8_SCHED __builtin_amdgcn_sched_barrier(0)
    Unit cur, nxt; int ui = 0;
    if (!S.next(0, cur)) { seam([]() {}); return; }
    f32x4 acc[2][2][4][2];
#pragma unroll
    for (int a = 0; a < 2; ++a)
#pragma unroll
        for (int b = 0; b < 2; ++b)
#pragma unroll
            for (int m = 0; m < 4; ++m)
#pragma unroll
                for (int n = 0; n < 2; ++n) acc[a][b][m][n] = (f32x4){0.f, 0.f, 0.f, 0.f};
    bf16x8 At[4][2], B0[2][2], B1[2][2];
    unsigned cA = PG8_AOFF(cur), cB = (unsigned)cur.pn * tstepB;
    S.a_ready(cur);
    if constexpr (SP2) {
        seam([&]() { PG8_STAGE_B(PG8_SB(0, 0), cB, voffB); PG8_STAGE_B(PG8_SB(0, 1), cB + hstepB, voffB); PG8_STAGE_B(PG8_SB(1, 0), cB + kstep, voffB); PG8_STAGE_B(PG8_SB(1, 1), cB + hstepB + kstep, voffB); });
        PG8_STAGE_A(PG8_SA(0, 0), cA, voffA); PG8_STAGE_A(PG8_SA(0, 1), cA + hstepA, voffA); PG8_STAGE_A(PG8_SA(1, 0), cA + kstep, voffA);
        E.after_issue(S, opaque_tid());
        if (wr == 1) PG8_BAR;
        PG8_WAIT_V(4); PG8_BAR;
        PG8_WAIT_V(2); PG8_BAR;
    } else {
        PG8_STAGE_B(PG8_SB(0, 0), cB, voffB); PG8_STAGE_A(PG8_SA(0, 0), cA, voffA); PG8_STAGE_B(PG8_SB(0, 1), cB + hstepB, voffB); PG8_STAGE_A(PG8_SA(0, 1), cA + hstepA, voffA);
        if (wr == 1) PG8_BAR;
        PG8_WAIT_V(4); PG8_BAR;
        PG8_STAGE_B(PG8_SB(1, 0), cB + kstep, voffB); PG8_STAGE_A(PG8_SA(1, 0), cA + kstep, voffA); PG8_STAGE_B(PG8_SB(1, 1), cB + hstepB + kstep, voffB);
        PG8_WAIT_V(6); PG8_BAR;
    }
    for (;;) {
        const bool has_next = S.next(ui + 1, nxt);
        const unsigned nA = has_next ? PG8_AOFF(nxt) : cA, nB = has_next ? (unsigned)nxt.pn * tstepB : cB;
        for (int t = 0; t < nt; t += 2) {
            const bool last = (t == nt - 2);
            const unsigned a1 = cA + (unsigned)(t + 1) * kstep;
            const unsigned a2 = last ? nA : cA + (unsigned)(t + 2) * kstep, b2 = last ? nB : cB + (unsigned)(t + 2) * kstep;
            const unsigned a3 = a2 + kstep, b3 = b2 + kstep;
            if (last && has_next) S.a_ready(nxt);
            if constexpr (SP2) {
            PG8_STAGE_A(PG8_SA(1, 1), a1 + hstepA, voffA); PG8_SCHED; PG8_LDB(B0, 0, 0); PG8_LDB(B1, 0, 1); PG8_SCHED; PG8_LDA(At, 0, 0);
            PG8_WAIT_V(8); PG8_WAIT_L(0); PG8_BAR; PG8_MMA(0, 0, At, B0); PG8_MMA(0, 1, At, B1); PG8_BAR; PG8_SCHED;
            PG8_STAGE_B(PG8_SB(0, 0), b2, voffB); PG8_STAGE_B(PG8_SB(0, 1), b2 + hstepB, voffB); PG8_STAGE_A(PG8_SA(0, 0), a2, voffA); PG8_SCHED; PG8_LDA(At, 0, 1);
            PG8_WAIT_V(8); PG8_WAIT_L(0); PG8_BAR; PG8_MMA(1, 0, At, B0); PG8_MMA(1, 1, At, B1); PG8_BAR; PG8_SCHED;
            PG8_STAGE_A(PG8_SA(0, 1), a2 + hstepA, voffA); PG8_SCHED; PG8_LDB(B0, 1, 0); PG8_LDB(B1, 1, 1); PG8_SCHED; PG8_LDA(At, 1, 0);
            PG8_WAIT_V(8); PG8_WAIT_L(0); PG8_BAR; PG8_MMA(0, 0, At, B0); PG8_MMA(0, 1, At, B1); PG8_BAR; PG8_SCHED;
            PG8_STAGE_B(PG8_SB(1, 0), b3, voffB); PG8_STAGE_B(PG8_SB(1, 1), b3 + hstepB, voffB); PG8_STAGE_A(PG8_SA(1, 0), a3, voffA); PG8_SCHED; PG8_LDA(At, 1, 1);
            PG8_WAIT_V(8); PG8_WAIT_L(0); PG8_BAR; PG8_MMA(1, 0, At, B0); PG8_MMA(1, 1, At, B1); PG8_BAR; PG8_SCHED;
            } else {
            PG8_LDB(B0, 0, 0); PG8_SCHED; PG8_LDA(At, 0, 0); PG8_STAGE_A(PG8_SA(1, 1), a1 + hstepA, voffA);
            PG8_WAIT_L(8); PG8_BAR; PG8_WAIT_L(0); PG8_MMA(0, 0, At, B0); PG8_BAR; PG8_SCHED;
            PG8_LDB(B1, 0, 1); PG8_STAGE_B(PG8_SB(0, 0), b2, voffB);
            PG8_BAR; PG8_WAIT_L(0); PG8_MMA(0, 1, At, B1); PG8_BAR;
            PG8_LDA(At, 0, 1); PG8_STAGE_A(PG8_SA(0, 0), a2, voffA);
            PG8_BAR; PG8_WAIT_L(0); PG8_MMA(1, 0, At, B0); PG8_BAR; PG8_SCHED;
            PG8_STAGE_B(PG8_SB(0, 1), b2 + hstepB, voffB);
            PG8_WAIT_V(6); PG8_BAR; PG8_MMA(1, 1, At, B1); PG8_BAR;
            PG8_LDB(B0, 1, 0); PG8_SCHED; PG8_LDA(At, 1, 0); PG8_STAGE_A(PG8_SA(0, 1), a2 + hstepA, voffA);
            PG8_WAIT_L(8); PG8_BAR; PG8_WAIT_L(0); PG8_MMA(0, 0, At, B0); PG8_BAR; PG8_SCHED;
            PG8_LDB(B1, 1, 1); PG8_STAGE_B(PG8_SB(1, 0), b3, voffB);
            PG8_BAR; PG8_WAIT_L(0); PG8_MMA(0, 1, At, B1); PG8_BAR;
            PG8_LDA(At, 1, 1); PG8_STAGE_A(PG8_SA(1, 0), a3, voffA);
            PG8_BAR; PG8_WAIT_L(0); PG8_MMA(1, 0, At, B0); PG8_BAR; PG8_SCHED;
            PG8_STAGE_B(PG8_SB(1, 1), b3 + hstepB, voffB);
            PG8_WAIT_V(6); PG8_BAR; PG8_MMA(1, 1, At, B1); PG8_BAR;
            }
        }
        if constexpr (ALIGN_EPI) { if (wr == 0) PG8_BAR; }
        if constexpr (!Epi::AFTER_DRAIN) { const int t2 = opaque_tid(), w2 = __builtin_amdgcn_readfirstlane(t2 >> 6);
            E(acc, cur, w2 >> 2, w2 & 3, t2 & 15, (t2 & 63) >> 4); S.done(cur); }
        if (!has_next) break;
#pragma unroll
        for (int a = 0; a < 2; ++a)
#pragma unroll
            for (int b = 0; b < 2; ++b)
#pragma unroll
                for (int m = 0; m < 4; ++m)
#pragma unroll
                    for (int n = 0; n < 2; ++n) acc[a][b][m][n] = (f32x4){0.f, 0.f, 0.f, 0.f};
        cur = nxt; cA = nA; cB = nB; ++ui;
        if constexpr (ALIGN_EPI) { if (wr == 1) PG8_BAR; }
    }
    PG8_WAIT_V(0);
    if constexpr (!ALIGN_EPI) { if (wr == 0) PG8_BAR; }
    PG8_BAR;
    if constexpr (Epi::AFTER_DRAIN) { E.fused(acc, cur, wr, wc, fr, fq, lds, wid, lane); S.done(cur); }
#undef PG8_AOFF
#undef PG8_SA
#undef PG8_SB
#undef PG8_STAGE_X
#undef PG8_STAGE_A
#undef PG8_STAGE_B
#undef PG8_LDA
#undef PG8_LDB
#undef PG8_MMA
#undef PG8_WAIT_V
#undef PG8_WAIT_L
#undef PG8_BAR
#undef PG8_SCHED
}
}
namespace fox {
typedef unsigned short bf16;
typedef short bf16x8 __attribute__((ext_vector_type(8)));
typedef short s16x4 __attribute__((ext_vector_type(4)));
typedef float f32x16 __attribute__((ext_vector_type(16)));
typedef float f32x4 __attribute__((ext_vector_type(4)));
typedef unsigned u32x4 __attribute__((ext_vector_type(4)));
constexpr int D = 128, T = 4096, NH = 16, OLD = 2048;
constexpr int NW = 8, QBLK = 32, KVBLK = 64, QB = NW * QBLK;
constexpr int SHM_V = KVBLK * D * 2, SHM_K = KVBLK * D * 2;
constexpr int LDS_WS = 2 * SHM_V + 2 * SHM_K, LDS_F = LDS_WS + NW * 64 * 4, LDS_BYTES = LDS_F + T * 4;
constexpr float THR = 8.f;
constexpr float LOG2E = 1.4426950408889634f;
constexpr float QSCALE = LOG2E * 0.08838834764831845f;

#define KSWZ(row, colB) ((row) * 256 + ((colB) ^ (((row) & 7) << 4)))
#define SBAR() __builtin_amdgcn_sched_barrier(0)
__device__ __forceinline__ int v_st(int k, int c) { const int kk = (k & ~0xC) | ((k & 4) << 1) | ((k & 8) >> 1); return ((kk >> 3) * 4 + (c >> 5)) * 512 + ((kk & 7) * 32 + (c & 31)) * 2; }
__device__ __forceinline__ int v_rd_base(int lane) { return ((lane & 3) << 3) | (((lane >> 2) & 3) << 6) | (((lane >> 4) & 1) << 5) | (((lane >> 5) & 1) << 8); }
constexpr int v_rd_off(int d0, int ks, int half) { return d0 * 512 + ks * 4096 + half * 2048; }
__device__ __forceinline__ int crow(int r, int hi) { return (r & 3) + 8 * (r >> 2) + 4 * hi; }
__device__ __forceinline__ unsigned cvtpk(float lo, float hi) {
    unsigned r; asm volatile("v_cvt_pk_bf16_f32 %0, %1, %2" : "=v"(r) : "v"(lo), "v"(hi)); return r;
}
__device__ __forceinline__ bf16x8 load8(const bf16* p) { return *reinterpret_cast<const bf16x8*>(p); }
__device__ __forceinline__ void mask_tile(f32x16& p0, f32x16& p1, int dq) {
    const float NEG = -__builtin_inff();
#pragma unroll
    for (int r = 0; r < 16; ++r) {
        const int c = (r & 3) + 8 * (r >> 2);
        if (dq - c < 0) p0[r] = NEG;
        if (dq - c - 32 < 0) p1[r] = NEG;
    }
}
__device__ __forceinline__ void partialSM(f32x16& p0, f32x16& p1, float& m_reg, float& mn, float& alpha) {
    float pmax = p0[0];
#pragma unroll
    for (int r = 1; r < 16; ++r) pmax = fmaxf(pmax, p0[r]);
#pragma unroll
    for (int r = 0; r < 16; ++r) pmax = fmaxf(pmax, p1[r]);
    { auto rr = __builtin_amdgcn_permlane32_swap(__float_as_uint(pmax), __float_as_uint(pmax), false, false);
      pmax = fmaxf(__uint_as_float(rr[0]), __uint_as_float(rr[1])); }
    if (__builtin_expect(__all((pmax - m_reg) <= THR), 1)) { mn = m_reg; alpha = 1.f; }
    else { mn = fmaxf(m_reg, pmax); alpha = __builtin_amdgcn_exp2f(m_reg - mn); m_reg = mn; }
#pragma unroll
    for (int r = 0; r < 16; ++r) p0[r] = p0[r] - mn;
#pragma unroll
    for (int r = 0; r < 16; ++r) p1[r] = p1[r] - mn;
#pragma unroll
    for (int r = 0; r < 16; ++r) p0[r] = __builtin_amdgcn_exp2f(p0[r]);
}
__device__ __forceinline__ void finishSM(f32x16& p0, f32x16& p1, float alpha, float& l_reg, bf16x8& pa0, bf16x8& pa1, bf16x8& pa2, bf16x8& pa3) {
#pragma unroll
    for (int r = 0; r < 16; ++r) p1[r] = __builtin_amdgcn_exp2f(p1[r]);
    float ps = 0;
#pragma unroll
    for (int r = 0; r < 16; ++r) ps += p0[r];
#pragma unroll
    for (int r = 0; r < 16; ++r) ps += p1[r];
    { auto rr = __builtin_amdgcn_permlane32_swap(__float_as_uint(ps), __float_as_uint(ps), false, false);
      ps = __uint_as_float(rr[0]) + __uint_as_float(rr[1]); }
    l_reg = l_reg * alpha + ps;
#define PK4(P, B_, OUT) do { unsigned a0 = cvtpk(P[B_+0], P[B_+1]), a1 = cvtpk(P[B_+2], P[B_+3]);                          \
        unsigned b0 = cvtpk(P[B_+4], P[B_+5]), b1 = cvtpk(P[B_+6], P[B_+7]);                                             \
        auto r0 = __builtin_amdgcn_permlane32_swap(a0, b0, false, false); auto r1 = __builtin_amdgcn_permlane32_swap(a1, b1, false, false); \
        u32x4 w = {r0[0], r1[0], r0[1], r1[1]}; OUT = *reinterpret_cast<bf16x8*>(&w); } while (0)
    PK4(p0, 0, pa0); PK4(p0, 8, pa1); PK4(p1, 0, pa2); PK4(p1, 8, pa3);
#undef PK4
}
template <int KB>
__device__ __forceinline__ void qkt(f32x16& p0, f32x16& p1, const char* K_lds, int r32, int hi, const bf16x8* qr, float fqv, const float* fk) {
#pragma unroll
    for (int g = 0; g < 4; ++g) {
        const f32x4 a = *reinterpret_cast<const f32x4*>(fk + 8 * g), b = *reinterpret_cast<const f32x4*>(fk + 32 + 8 * g);
#pragma unroll
        for (int j = 0; j < 4; ++j) { p0[4 * g + j] = fqv - a[j]; p1[4 * g + j] = fqv - b[j]; }
    }
    const char* kb[4];
#pragma unroll
    for (int dd = 0; dd < 4; ++dd) kb[dd] = K_lds + KB * SHM_K + KSWZ(r32, (dd * 16 + hi * 8) * 2);
#pragma unroll
    for (int d0 = 0; d0 < 8; ++d0) { const char* a = kb[d0 & 3] + (d0 >> 2) * 128;
        bf16x8 b0 = *reinterpret_cast<const bf16x8*>(a);
        bf16x8 b1 = *reinterpret_cast<const bf16x8*>(a + 32 * 256);
        p0 = __builtin_amdgcn_mfma_f32_32x32x16_bf16(b0, qr[d0], p0, 0, 0, 0);
        p1 = __builtin_amdgcn_mfma_f32_32x32x16_bf16(b1, qr[d0], p1, 0, 0, 0); }
}
template <int VB>
__device__ __forceinline__ void pv_tile(f32x16* o, int vb0, bf16x8 pa0, bf16x8 pa1, bf16x8 pa2, bf16x8 pa3) {
#define TRRD(dst, off) asm volatile("ds_read_b64_tr_b16 %0, %1 offset:%2" : "=&v"(dst) : "v"(vb0), "i"(off) : "memory")
#define PV_D0(d0) do { s16x4 l0, l1, l2, l3, h0, h1, h2, h3; constexpr int b_ = VB * SHM_V + v_rd_off(d0, 0, 0);     \
        TRRD(l0, b_); TRRD(h0, b_ + 2048); TRRD(l1, b_ + 4096); TRRD(h1, b_ + 6144); TRRD(l2, b_ + 8192); TRRD(h2, b_ + 10240); TRRD(l3, b_ + 12288); TRRD(h3, b_ + 14336); \
        asm volatile("s_waitcnt lgkmcnt(0)" ::: "memory"); SBAR();                 \
        o[d0] = __builtin_amdgcn_mfma_f32_32x32x16_bf16(pa0, (bf16x8){l0[0], l0[1], l0[2], l0[3], h0[0], h0[1], h0[2], h0[3]}, o[d0], 0, 0, 0);   \
        o[d0] = __builtin_amdgcn_mfma_f32_32x32x16_bf16(pa1, (bf16x8){l1[0], l1[1], l1[2], l1[3], h1[0], h1[1], h1[2], h1[3]}, o[d0], 0, 0, 0);   \
        o[d0] = __builtin_amdgcn_mfma_f32_32x32x16_bf16(pa2, (bf16x8){l2[0], l2[1], l2[2], l2[3], h2[0], h2[1], h2[2], h2[3]}, o[d0], 0, 0, 0);   \
        o[d0] = __builtin_amdgcn_mfma_f32_32x32x16_bf16(pa3, (bf16x8){l3[0], l3[1], l3[2], l3[3], h3[0], h3[1], h3[2], h3[3]}, o[d0], 0, 0, 0); } while (0)
    PV_D0(0); PV_D0(1); PV_D0(2); PV_D0(3);
#undef PV_D0
#undef TRRD
}

struct BlockRef { const bf16* Q; const bf16* K; const bf16* V; bf16* O; int P0; int JLO; float THR; };
struct Stage { bf16x8 st_v0, st_v1, st_k0, st_k1; };
struct Seam { bf16x8 qr[8]; bf16x8 st_v0, st_v1, st_k0, st_k1; };
#define ROW(p, k0, rr) ((p) + (size_t)((k0) + (rr)) * D + sc)
#define VMW() asm volatile("s_waitcnt vmcnt(0)" ::: "memory")
#define VMWN(n) asm volatile("s_waitcnt vmcnt(%0)" :: "i"(n) : "memory")
#define SLOAD_X(X, Kp, Vp, k0) do { X.st_v0 = load8(ROW(Vp, k0, sr)); X.st_v1 = load8(ROW(Vp, k0, 32 + sr));              \
                         X.st_k0 = load8(ROW(Kp, k0, sr)); X.st_k1 = load8(ROW(Kp, k0, 32 + sr)); } while (0)
#define SWRITE_XK(X, bf) do { *(bf16x8*)(K_lds + (bf) * SHM_K + kws) = X.st_k0; *(bf16x8*)(K_lds + (bf) * SHM_K + kws + 32 * 256) = X.st_k1; } while (0)
#define SWRITE_XV(X, bf) do { *(bf16x8*)(V_lds + (bf) * SHM_V + vst0) = X.st_v0; *(bf16x8*)(V_lds + (bf) * SHM_V + vst1) = X.st_v1; } while (0)
#define SWRITE_X(X, bf) do { SWRITE_XV(X, bf); SWRITE_XK(X, bf); } while (0)
#define SLOAD_H(Kp, Vp, k0) SLOAD_X(S, Kp, Vp, k0)
#define SWRITE_HK(bf) SWRITE_XK(S, bf)
#define SWRITE_HV(bf) SWRITE_XV(S, bf)
#define SWRITE_H(bf) SWRITE_X(S, bf)
__device__ __forceinline__ void fox_prime(const BlockRef& cur, char* lds, Seam& S) {
    const int tid = opaque_tid(), wid = __builtin_amdgcn_readfirstlane(tid >> 6), lane = tid & 63, r32 = lane & 31, hi = lane >> 5;
    const int sr = tid >> 4, sc = (tid & 15) * 8, kws = KSWZ(sr, sc * 2); char* K_lds = lds + 2 * SHM_V;
    const int kb0 = cur.JLO * KVBLK;
#pragma unroll
    for (int d0 = 0; d0 < 8; ++d0) S.qr[d0] = load8(cur.Q + (size_t)(wid * QBLK + r32) * D + d0 * 16 + hi * 8);
    SLOAD_H(cur.K, cur.V, kb0); VMW(); SWRITE_HK(0);
    __syncthreads();
}
__device__ __forceinline__ void fox_block(const BlockRef& cur, const BlockRef& nxt, char* lds, Seam& S) {
    const int tid = opaque_tid(), wid = __builtin_amdgcn_readfirstlane(tid >> 6), lane = tid & 63, r32 = lane & 31, hi = lane >> 5;
    const int j_lo = cur.JLO;
    const int j_hi = (cur.P0 + QB - 1) / KVBLK + 1;
    const int NT = j_hi - j_lo;
    const int kbn = nxt.JLO * KVBLK;
    const int qlo = cur.P0 + wid * QBLK, qm = qlo + r32 - 4 * hi;
    char* V_lds = lds; char* K_lds = lds + 2 * SHM_V;
    float* ws = (float*)(lds + LDS_WS) + wid * 64; float* li_l = ws, * al_l = ws + 32;
    const float* Fl = (const float*)(lds + LDS_F);
    const float fqv = Fl[qlo + r32];
    int tl_w = 0;
    if (cur.THR >= 0.f) {
        const bool dead = (KVBLK * lane + KVBLK - 1 < qlo) && (Fl[qlo] - Fl[KVBLK * lane + KVBLK - 1] <= -cur.THR);
        const int jw = __builtin_amdgcn_readfirstlane((int)__builtin_ctzll(~__ballot(dead)));
        tl_w = jw > j_lo ? jw - j_lo : 0;
    }
    const int th_w_ = (qlo + QBLK - 1) / KVBLK + 1 - j_lo, th_w = th_w_ < NT ? th_w_ : NT;
    float m_reg = -1e30f, l_reg = 0; f32x16 o[4] = {};
    const int sr = tid >> 4, sc = (tid & 15) * 8, vst0 = v_st(sr, sc), vst1 = v_st(32 + sr, sc), kws = KSWZ(sr, sc * 2);
    const int vb0 = (int)(uintptr_t)V_lds + v_rd_base(lane);
    const bf16* Kh = cur.K; const bf16* Vh = cur.V;
#define RESC(a) do { if (__any((a) < 1.f)) { if (hi == 0) al_l[r32] = (a); asm volatile("s_waitcnt lgkmcnt(0)" ::: "memory");              \
                     for (int d_ = 0; d_ < 4; ++d_) for (int r = 0; r < 16; ++r) o[d_][r] *= al_l[crow(r, hi)]; } } while (0)
#define KBASE(t) ((j_lo + (t)) * KVBLK)
#define FK(t) (Fl + KBASE(t) + 4 * hi)
#define MASKT(P0_, P1_, t) do { const int kb_ = KBASE(t); if (kb_ + KVBLK - 1 > qlo) mask_tile(P0_, P1_, qm - kb_); } while (0)
    Stage T;
    SWRITE_HV(0);
    if (NT > 1) SLOAD_X(T, Kh, Vh, KBASE(1));
    __syncthreads();
    f32x16 p0, p1; float mn, al; bf16x8 pa0, pa1, pa2, pa3;
#define TILE(t, B, XB, XN) do {                                                                                                \
        if ((t) + 2 < NT) { SLOAD_X(XB, Kh, Vh, KBASE((t) + 2)); SBAR(); }                                                      \
        if ((t) >= tl_w && (t) < th_w) {                                                                                        \
        qkt<B>(p0, p1, K_lds, r32, hi, S.qr, fqv, FK(t)); MASKT(p0, p1, (t)); partialSM(p0, p1, m_reg, mn, al); RESC(al);      \
        finishSM(p0, p1, al, l_reg, pa0, pa1, pa2, pa3); SBAR(); pv_tile<B>(o, vb0, pa0, pa1, pa2, pa3); }                     \
        if ((t) + 1 < NT) { if ((t) + 2 < NT) VMWN(4); else VMW(); SWRITE_X(XN, 1 - (B)); }                                     \
        __syncthreads(); } while (0)
    int t = 0;
    for (; t + 1 < NT; t += 2) { TILE(t, 0, S, T); TILE(t + 1, 1, T, S); }
    if (t < NT) TILE(t, 0, S, T);
    SLOAD_H(nxt.K, nxt.V, kbn); SBAR();
#pragma unroll
    for (int d0 = 0; d0 < 8; ++d0) S.qr[d0] = load8(nxt.Q + (size_t)(wid * QBLK + r32) * D + d0 * 16 + hi * 8);
    SBAR();
    VMWN(8); SWRITE_HK(0); SBAR();
    if (hi == 0) li_l[r32] = l_reg; asm volatile("s_waitcnt lgkmcnt(0)" ::: "memory");
    float rli[16];
#pragma unroll
    for (int r = 0; r < 16; ++r) rli[r] = __builtin_amdgcn_rcpf(li_l[crow(r, hi)]);
    bf16* Ow = cur.O + (size_t)(wid * QBLK) * OLD;
    char* ost = lds + LDS_BYTES + wid * 4096;
#pragma unroll
    for (int ps = 0; ps < 2; ++ps) {
#pragma unroll
        for (int r = 0; r < 16; ++r) { const int orow = crow(r, hi);
#pragma unroll
            for (int dd = 0; dd < 2; ++dd) { const float v = o[2 * ps + dd][r] * rli[r];
                *(unsigned short*)(ost + orow * 128 + (dd * 32 + r32) * 2) = (unsigned short)cvtpk(v, v); } }
        asm volatile("s_waitcnt lgkmcnt(0)" ::: "memory");
#pragma unroll
        for (int i = 0; i < 4; ++i) { const int row = (lane >> 3) + 8 * i, ch = lane & 7;
            const u32x4 w = *(const u32x4*)(ost + row * 128 + ch * 16);
            *(u32x4*)(Ow + (size_t)row * OLD + ps * 64 + ch * 8) = w; }
        asm volatile("s_waitcnt lgkmcnt(0)" ::: "memory");
    }
    __syncthreads();
#undef RESC
#undef KBASE
#undef FK
#undef MASKT
#undef TILE
}
#undef ROW
#undef VMW
#undef VMWN
#undef SLOAD_H
#undef SWRITE_HK
#undef SWRITE_HV
#undef SWRITE_H
#undef SLOAD_X
#undef SWRITE_XK
#undef SWRITE_XV
#undef SWRITE_X
#undef SBAR
#undef KSWZ
}

#define GAS __attribute__((address_space(1)))
#define LAS __attribute__((address_space(3)))
typedef unsigned short bf16;
typedef unsigned v4u __attribute__((ext_vector_type(4)));
typedef float f32x4 __attribute__((ext_vector_type(4)));
typedef short bf16x8 __attribute__((ext_vector_type(8)));
typedef GAS unsigned gu32;
typedef GAS unsigned long long gu64;
#define RLX_AGENT __ATOMIC_RELAXED, __HIP_MEMORY_SCOPE_AGENT
#define LDS_WAIT() asm volatile("s_waitcnt lgkmcnt(0)" ::: "memory")
#define VM_WAIT() asm volatile("s_waitcnt vmcnt(0)" ::: "memory")
__device__ __forceinline__ unsigned long long rt() { return __builtin_amdgcn_s_memrealtime(); }
__device__ __forceinline__ unsigned f2bf(float f) { unsigned u = __builtin_bit_cast(unsigned, f); return (u + 0x7fffu + ((u >> 16) & 1u)) >> 16; }
__device__ __forceinline__ unsigned pk2(float lo, float hi) { return f2bf(lo) | (f2bf(hi) << 16); }

#define XB_TMO      128
#define XB_XCNT(j)  (256  + 64 * (j))
#define XB_XSUB(j)  (1280 + 64 * (j))
#define XB_XGEN(j)  (2304 + 64 * (j))
#define XB_TOP      3328
#define XB_TOPGEN   3392
#define XCD_BAR_WORDS 3456
#define XB_SPIN_CAP (1u << 21)

__device__ __forceinline__ unsigned xb_ld(unsigned* p)              { return __hip_atomic_load(p, __ATOMIC_RELAXED, __HIP_MEMORY_SCOPE_AGENT); }
__device__ __forceinline__ unsigned xb_add(unsigned* p, unsigned v) { return __hip_atomic_fetch_add(p, v, __ATOMIC_RELAXED, __HIP_MEMORY_SCOPE_AGENT); }
__device__ __forceinline__ unsigned xb_xcc_id() { return (unsigned)__builtin_amdgcn_s_getreg((3 << 11) | 20) & 0xFu; }
#define XB_SPIN(cond, bar) do { unsigned _sp = 0; while (cond) { __builtin_amdgcn_s_sleep(1); \
    if ((++_sp & 255u) == 0u) { if (xb_ld(&(bar)[XB_TMO])) break; if (_sp > XB_SPIN_CAP) { atomicAdd(&(bar)[XB_TMO], 1u); break; } } } } while (0)

struct XcdBarrier {
    unsigned* bar; unsigned x;
    volatile LAS unsigned* st;
};

__device__ __forceinline__ XcdBarrier xcd_barrier_post(unsigned* bar, volatile LAS unsigned* st) {
    XcdBarrier b; b.bar = bar; b.x = xb_xcc_id(); b.st = st;
    if (threadIdx.x == 0) st[3] = xb_add(&bar[XB_XCNT(b.x)], 1u);
    return b;
}
__device__ __forceinline__ void xcd_barrier_complete(unsigned* bar, unsigned x, unsigned& nloc, unsigned& nx, unsigned& even) {
    const unsigned G = gridDim.x * gridDim.y * gridDim.z;
    unsigned sum, cnt, mine, n32, sp = 0u;
    for (;;) {
        sum = 0u; cnt = 0u; mine = 0u; n32 = 0u;
#pragma unroll
        for (unsigned j = 0; j < 16; ++j) { const unsigned c = xb_ld(&bar[XB_XCNT(j)]); sum += c; cnt += (c > 0u) ? 1u : 0u; mine = (j == x) ? c : mine; n32 += (j < 8u && c == 32u) ? 1u : 0u; }
        even = (sum == G && n32 == 8u && G == 256u) ? 1u : 2u;
        if (sum == G) break;
        __builtin_amdgcn_s_sleep(1);
        if ((++sp & 255u) == 0u) { if (xb_ld(&bar[XB_TMO])) break; if (sp > XB_SPIN_CAP) { atomicAdd(&bar[XB_TMO], 1u); break; } }
    }
    nloc = mine > 0u ? mine : 1u; nx = cnt > 0u ? cnt : 1u;
}

__device__ __forceinline__ void xcd_barrier(const XcdBarrier& b) {
    asm volatile("s_waitcnt vmcnt(0)" ::: "memory");
    __syncthreads();
    if (threadIdx.x == 0) {
        unsigned* bar = b.bar;
        __builtin_amdgcn_s_waitcnt(0);
        unsigned nloc = b.st[0], nx = b.st[1];
        if (nloc == 0u) { unsigned even; xcd_barrier_complete(bar, b.x, nloc, nx, even); b.st[0] = nloc; b.st[1] = nx; b.st[2] = even; }
        const unsigned old = xb_add(&bar[XB_XSUB(b.x)], 1u);
        const unsigned gen = old / nloc;
        if (old + 1u == (gen + 1u) * nloc) {
            __builtin_amdgcn_fence(__ATOMIC_RELEASE, "agent");
            asm volatile("s_waitcnt vmcnt(0)" ::: "memory");
            const unsigned og = xb_add(&bar[XB_TOP], 1u);
            const unsigned tg = og / nx;
            if (og + 1u == (tg + 1u) * nx) xb_add(&bar[XB_TOPGEN], 1u);
            else XB_SPIN(xb_ld(&bar[XB_TOPGEN]) == tg, bar);
            __builtin_amdgcn_fence(__ATOMIC_ACQUIRE, "agent");
            xb_add(&bar[XB_XGEN(b.x)], 1u);
            asm volatile("s_waitcnt vmcnt(0)" ::: "memory");
        } else {
            XB_SPIN(xb_ld(&bar[XB_XGEN(b.x)]) == gen, bar);
            __builtin_amdgcn_fence(__ATOMIC_ACQUIRE, "agent");
            asm volatile("s_waitcnt vmcnt(0)" ::: "memory");
        }
    }
    __syncthreads();
}

__device__ __forceinline__ void xcd_local_barrier(const XcdBarrier& b) {
    asm volatile("s_waitcnt vmcnt(0)" ::: "memory");
    __syncthreads();
    if (threadIdx.x == 0) {
        unsigned* bar = b.bar;
        __builtin_amdgcn_s_waitcnt(0);
        const unsigned nloc = b.st[0];
        const unsigned old = xb_add(&bar[XB_XSUB(b.x)], 1u);
        const unsigned gen = old / nloc;
        if (old + 1u == (gen + 1u) * nloc) xb_add(&bar[XB_XGEN(b.x)], 1u);
        else XB_SPIN(xb_ld(&bar[XB_XGEN(b.x)]) == gen, bar);
        __builtin_amdgcn_fence(__ATOMIC_ACQUIRE, "agent");
        asm volatile("s_waitcnt vmcnt(0)" ::: "memory");
    }
    __syncthreads();
}

template <class F> __device__ __forceinline__ void xcd_barrier_mid(const XcdBarrier& b, F&& mid) {
    asm volatile("s_waitcnt vmcnt(0)" ::: "memory");
    __syncthreads();
    unsigned gen = 0u, tg = 0u; bool lead = false, lastx = false;
    if (threadIdx.x == 0) {
        unsigned* bar = b.bar;
        __builtin_amdgcn_s_waitcnt(0);
        unsigned nloc = b.st[0], nx = b.st[1];
        if (nloc == 0u) { unsigned even; xcd_barrier_complete(bar, b.x, nloc, nx, even); b.st[0] = nloc; b.st[1] = nx; b.st[2] = even; }
        const unsigned old = xb_add(&bar[XB_XSUB(b.x)], 1u);
        gen = old / nloc; lead = (old + 1u == (gen + 1u) * nloc);
        if (lead) {
            __builtin_amdgcn_fence(__ATOMIC_RELEASE, "agent");
            asm volatile("s_waitcnt vmcnt(0)" ::: "memory");
            const unsigned og = xb_add(&bar[XB_TOP], 1u);
            tg = og / nx; lastx = (og + 1u == (tg + 1u) * nx);
        }
    }
    mid();
    if (threadIdx.x == 0) {
        unsigned* bar = b.bar;
        if (lead) {
            if (lastx) xb_add(&bar[XB_TOPGEN], 1u); else XB_SPIN(xb_ld(&bar[XB_TOPGEN]) == tg, bar);
            __builtin_amdgcn_fence(__ATOMIC_ACQUIRE, "agent");
            xb_add(&bar[XB_XGEN(b.x)], 1u);
            asm volatile("s_waitcnt vmcnt(0)" ::: "memory");
        } else {
            XB_SPIN(xb_ld(&bar[XB_XGEN(b.x)]) == gen, bar);
            __builtin_amdgcn_fence(__ATOMIC_ACQUIRE, "agent");
            asm volatile("s_waitcnt vmcnt(0)" ::: "memory");
        }
    }
    __syncthreads();
}
template <class F> __device__ __forceinline__ void xcd_local_barrier_mid(const XcdBarrier& b, F&& mid) {
    asm volatile("s_waitcnt vmcnt(0)" ::: "memory");
    __syncthreads();
    unsigned gen = 0u; bool lead = false;
    if (threadIdx.x == 0) {
        unsigned* bar = b.bar;
        __builtin_amdgcn_s_waitcnt(0);
        const unsigned nloc = b.st[0];
        const unsigned old = xb_add(&bar[XB_XSUB(b.x)], 1u);
        gen = old / nloc; lead = (old + 1u == (gen + 1u) * nloc);
        if (lead) xb_add(&bar[XB_XGEN(b.x)], 1u);
    }
    mid();
    if (threadIdx.x == 0) {
        unsigned* bar = b.bar;
        if (!lead) XB_SPIN(xb_ld(&bar[XB_XGEN(b.x)]) == gen, bar);
        __builtin_amdgcn_fence(__ATOMIC_ACQUIRE, "agent");
        asm volatile("s_waitcnt vmcnt(0)" ::: "memory");
    }
    __syncthreads();
}
struct SeamBar {
    const XcdBarrier& bar; int kind;
    template <class F> __device__ __forceinline__ void operator()(F&& f) const { if (kind == 2) xcd_barrier_mid(bar, f); else if (kind == 1) xcd_local_barrier_mid(bar, f); else f(); }
};

constexpr int NWAVES = 8;
constexpr int BATCH = 2, SEQ = 4096, DMODEL = 2048, DFF = 5632, DEPTH = 4, NHEAD = 16, HDIM = 128;
constexpr int M = BATCH * SEQ;
constexpr int NGU = 2 * DFF;
constexpr int NQKV = 3 * DMODEL;
constexpr int WIN_LD = 3 * DMODEL + NHEAD;
#ifndef MK_MULTI
#define MK_MULTI 0
#endif
#ifndef PROBE_AMP
#define PROBE_AMP 1
#endif
#ifndef PROBE_CLASS
#define PROBE_CLASS -1
#endif
constexpr int N_PHASES = 1 + 16 + 4 + 6;
#ifndef FOX_SKIP
#define FOX_SKIP 1
#endif

constexpr size_t MiB = 1u << 20;
constexpr size_t WS_CTL = 0, CTL_ZERO_BYTES = 16384;
constexpr size_t SZ_WGU = (size_t)NGU * DMODEL * 2, SZ_WD = (size_t)DMODEL * DFF * 2;
constexpr size_t SZ_WFIN = (size_t)NQKV * DMODEL * 2, SZ_WFOUT = (size_t)DMODEL * DMODEL * 2, SZ_WPOOL = (size_t)DMODEL * 512 * 2;
constexpr size_t WS_WGU = 1 * MiB;
constexpr size_t WS_WD = WS_WGU + 8 * SZ_WGU;
constexpr size_t WS_WFIN = WS_WD + 8 * SZ_WD;
constexpr size_t WS_WFOUT = WS_WFIN + 2 * SZ_WFIN;
constexpr size_t WS_WPOOL = WS_WFOUT + 2 * SZ_WFOUT;
constexpr size_t WS_WFT = WS_WPOOL + 2 * SZ_WPOOL;
constexpr size_t WS_GQK = WS_WFT + 2 * 16 * 2048 * 4;
constexpr size_t WS_SSQ = WS_GQK + 4096;
constexpr size_t WS_LF = WS_SSQ + (size_t)M * 32 * 4;
constexpr size_t WS_XG = WS_LF + (size_t)32 * 4096 * 4;
constexpr size_t WS_HACT = WS_XG + (size_t)M * DMODEL * 2;
constexpr size_t WS_Q = WS_HACT + (size_t)M * DFF * 2;
constexpr size_t WS_K = WS_Q + (size_t)M * DMODEL * 2;
constexpr size_t WS_V = WS_K + (size_t)M * DMODEL * 2;
constexpr size_t WS_O = WS_V + (size_t)M * DMODEL * 2;
constexpr size_t WS_XG2 = WS_O + (size_t)M * DMODEL * 2;
constexpr size_t WS_SSQ2 = WS_XG2 + (size_t)M * DMODEL * 2;
constexpr size_t WS_END = WS_SSQ2 + (size_t)M * 32 * 4;
static_assert(WS_WGU % 256 == 0 && WS_WD % 256 == 0 && WS_WFIN % 256 == 0 && WS_XG % 256 == 0 && WS_HACT % 256 == 0 && WS_Q % 256 == 0 && WS_O % 256 == 0 && WS_XG2 % 256 == 0 && WS_SSQ2 % 256 == 0, "alignment");
constexpr int CW_BAR = 0;

constexpr int RING_OFF = 0, RING_BYTES = 131072;
constexpr int LDSCTL_OFF = RING_BYTES, MISC_OFF = LDSCTL_OFF + 320, XCH_OFF = LDSCTL_OFF + 1024, RTAB_OFF = XCH_OFF + 8192;
constexpr int LDS_BYTES = 147456;
static_assert(MISC_OFF + 128 <= XCH_OFF && RTAB_OFF + 6 * 256 * 4 <= LDS_BYTES && fox::LDS_BYTES + 8 * 4096 <= RING_BYTES, "LDS map (the attention body adds a 4 KiB O stage per wave above its own LDS)");


struct Args { const float* in[17]; float* out; unsigned char* ws; int ph_lo, ph_hi; };
struct Frame {
    LAS unsigned char* lds;
    volatile LAS unsigned* MISC;
    gu32* ctl;
    int tid, lane, wave, vcu, G, rowpart;
};
typedef unsigned long long u64_t;
#define GIN(a_, k_) ((const float*)(const GAS float*)(a_).in[k_])
__device__ __forceinline__ float wave_sum(float v, int lane) {
#pragma unroll
    for (int o = 1; o < 64; o <<= 1) v += shfl_idx(v, lane ^ o);
    return v;
}
__device__ __forceinline__ float bf2f(unsigned short u) { return __builtin_bit_cast(float, (unsigned)u << 16); }

struct CvItem { const float* src; int ldw; bf16* dst; int kd; const float* gk; };
constexpr int CV_FFN = 3 * 5632, CV_FOX = 6144 + 2048, CV_POOL = 4 * 128;
#ifndef CV_SPLIT
#define CV_SPLIT(bx_) 5
#endif
constexpr int CV_TAIL = 13400;
constexpr int CV_PRO = 8 * CV_FFN + 2 * CV_FOX + 2 * CV_POOL - 7 * CV_TAIL;
constexpr int CV_TOTAL = 8 * CV_FFN + 2 * CV_FOX + 2 * CV_POOL;
constexpr int cv_reader_phase(int g) {
    constexpr int gu_ph[8] = {1, 5, 7, 12, 14, 18, 20, 25};
    if (g < CV_FFN) return gu_ph[0];
    g -= CV_FFN; if (g < CV_POOL) return 4;
    g -= CV_POOL; if (g < CV_FFN) return gu_ph[1];
    g -= CV_FFN; if (g < CV_FOX) return 9;
    g -= CV_FOX; if (g < 2 * CV_FFN) return gu_ph[2 + g / CV_FFN];
    g -= 2 * CV_FFN; if (g < CV_POOL) return 17;
    g -= CV_POOL; if (g < 2 * CV_FFN) return gu_ph[4 + g / CV_FFN];
    g -= 2 * CV_FFN; if (g < CV_FOX) return 22;
    g -= CV_FOX; return gu_ph[6 + g / CV_FFN];
}
constexpr bool cv_seams_ok() {
    constexpr int gu_ph[8] = {1, 5, 7, 12, 14, 18, 20, 25};
    constexpr int grid_after[8] = {0, 2, 9, 15, 19, 22, 22, 22};
    for (int s = 0; s < 7; ++s) {
        const int lo = CV_PRO + s * CV_TAIL, hi = lo + CV_TAIL;
        int first = 1000;
        for (int g = lo; g < hi; g += 64) { const int r = cv_reader_phase(g); if (r < first) first = r; }
        { const int r = cv_reader_phase(hi - 1); if (r < first) first = r; }
        bool ok = false;
        for (int k = 0; k < 8; ++k) if (grid_after[k] >= gu_ph[s] && grid_after[k] < first) ok = true;
        if (!ok) return false;
    }
    return true;
}
__device__ __forceinline__ CvItem cv_ffn(const Args& a, unsigned char* ws, int s, int q) {
    const int mat = q / 5632, i = q % 5632, L = s >> 1, f = s & 1; CvItem it;
    if (mat < 2) {
        const int kb = i / 176, nb = i % 176, n0 = 32 * nb;
        const float* Wm = (mat == 0 ? (f ? GIN(a, 14) : GIN(a, 2)) : (f ? GIN(a, 15) : GIN(a, 3))) + (size_t)L * DMODEL * DFF;
        it.src = Wm + (size_t)(64 * kb) * DFF + n0; it.ldw = DFF; it.gk = (f ? GIN(a, 13) : GIN(a, 1)) + (size_t)L * DMODEL + 64 * kb;
        const int drow = (n0 >> 7) * 256 + (n0 & 127) + mat * 128;
        it.dst = (bf16*)(ws + WS_WGU + (size_t)s * SZ_WGU) + (size_t)drow * DMODEL + 64 * kb; it.kd = DMODEL;
    } else {
        const int kb = i / 64, nb = i % 64, n0 = 32 * nb;
        const float* Wm = (f ? GIN(a, 16) : GIN(a, 4)) + (size_t)L * DFF * DMODEL;
        it.src = Wm + (size_t)(64 * kb) * DMODEL + n0; it.ldw = DMODEL; it.gk = nullptr;
        it.dst = (bf16*)(ws + WS_WD + (size_t)s * SZ_WD) + (size_t)n0 * DFF + 64 * kb; it.kd = DFF;
    }
    return it;
}
__device__ __forceinline__ CvItem cv_fox(const Args& a, unsigned char* ws, int j, int r) {
    CvItem it;
    if (r < 6144) { const int kb = r / 192, nb = r % 192, n0 = 32 * nb;
        it.src = GIN(a, 8) + (size_t)j * DMODEL * WIN_LD + (size_t)(64 * kb) * WIN_LD + n0; it.ldw = WIN_LD; it.gk = GIN(a, 5) + (size_t)(2 * j + 1) * DMODEL + 64 * kb;
        it.dst = (bf16*)(ws + WS_WFIN + (size_t)j * SZ_WFIN) + (size_t)n0 * DMODEL + 64 * kb; it.kd = DMODEL;
    } else { const int i = r - 6144, kb = i / 64, nb = i % 64, n0 = 32 * nb;
        it.src = GIN(a, 12) + (size_t)j * DMODEL * DMODEL + (size_t)(64 * kb) * DMODEL + n0; it.ldw = DMODEL; it.gk = nullptr;
        it.dst = (bf16*)(ws + WS_WFOUT + (size_t)j * SZ_WFOUT) + (size_t)n0 * DMODEL + 64 * kb; it.kd = DMODEL; }
    return it;
}
__device__ __forceinline__ CvItem cv_pool(const Args& a, unsigned char* ws, int j, int r) {
    const int jg = j * 4 + r / 128, i = r % 128, kb = i / 16, nb = i % 16, n0 = 32 * nb; CvItem it;
    it.src = GIN(a, 6) + (size_t)jg * 512 * 512 + (size_t)(64 * kb) * 512 + n0; it.ldw = 512; it.gk = GIN(a, 5) + (size_t)(2 * j) * DMODEL + (jg & 3) * 512 + 64 * kb;
    it.dst = (bf16*)(ws + WS_WPOOL) + (size_t)jg * 512 * 512 + (size_t)n0 * 512 + 64 * kb; it.kd = 512;
    return it;
}
__device__ __forceinline__ CvItem cv_decode(const Args& a, unsigned char* ws, int g) {
    if (g < CV_FFN) return cv_ffn(a, ws, 0, g);
    g -= CV_FFN; if (g < CV_POOL) return cv_pool(a, ws, 0, g);
    g -= CV_POOL; if (g < CV_FFN) return cv_ffn(a, ws, 1, g);
    g -= CV_FFN; if (g < CV_FOX) return cv_fox(a, ws, 0, g);
    g -= CV_FOX; if (g < 2 * CV_FFN) return cv_ffn(a, ws, 2 + g / CV_FFN, g % CV_FFN);
    g -= 2 * CV_FFN; if (g < CV_POOL) return cv_pool(a, ws, 1, g);
    g -= CV_POOL; if (g < 2 * CV_FFN) return cv_ffn(a, ws, 4 + g / CV_FFN, g % CV_FFN);
    g -= 2 * CV_FFN; if (g < CV_FOX) return cv_fox(a, ws, 1, g);
    g -= CV_FOX; return cv_ffn(a, ws, 6 + g / CV_FFN, g % CV_FFN);
}
__device__ __forceinline__ void cv_load(const CvItem& it, f32x4 (&v)[8], int lane) {
    asm volatile("" : "+v"(lane));
    const float* p = it.src + (size_t)(lane >> 3) * it.ldw + (lane & 7) * 4;
#pragma unroll
    for (int i = 0; i < 8; ++i) v[i] = __builtin_nontemporal_load((const f32x4*)(p + (size_t)(8 * i) * it.ldw));
}
__device__ __forceinline__ void cv_finish(const CvItem& it, const f32x4 (&v)[8], LAS float* scr, int lane) {
    asm volatile("" : "+v"(lane));
    const int kr = lane >> 3, n4 = (lane & 7) * 4;
#pragma unroll
    for (int i = 0; i < 8; ++i) *(LAS f32x4*)(scr + (8 * i + kr) * 32 + (n4 ^ (i << 2))) = v[i];
    const int c = lane & 7;
    f32x4 ga = {1.f, 1.f, 1.f, 1.f}, gb = {1.f, 1.f, 1.f, 1.f};
    if (it.gk) { ga = *(const f32x4*)(it.gk + 8 * c); gb = *(const f32x4*)(it.gk + 8 * c + 4); }
    LDS_WAIT(); asm volatile("" ::: "memory");
#pragma unroll
    for (int j = 0; j < 4; ++j) { const int n = (lane >> 3) + 8 * j; const LAS float* s = scr + (8 * c) * 32 + (n ^ (c << 2));
        v4u o; o.x = pg8::cvt_pk_bf16(s[0 * 32] * ga.x, s[1 * 32] * ga.y); o.y = pg8::cvt_pk_bf16(s[2 * 32] * ga.z, s[3 * 32] * ga.w); o.z = pg8::cvt_pk_bf16(s[4 * 32] * gb.x, s[5 * 32] * gb.y); o.w = pg8::cvt_pk_bf16(s[6 * 32] * gb.z, s[7 * 32] * gb.w);
        __builtin_nontemporal_store(o, (GAS v4u*)(it.dst + (size_t)n * it.kd + 8 * c)); }
    LDS_WAIT(); asm volatile("" ::: "memory");
}
__device__ __forceinline__ void cv_range(const Args& a, unsigned char* ws, int lo, int hi, int w, int nw, LAS float* scr, int lane) {
    int g = lo + 2 * w; if (g >= hi) return;
    const int step = 2 * nw;
    CvItem ia = cv_decode(a, ws, g), ib = cv_decode(a, ws, g + 1 < hi ? g + 1 : g), ja, jb;
    f32x4 va[8], vb[8], wa[8], wb[8];
    cv_load(ia, va, lane); cv_load(ib, vb, lane);
    for (;;) {
        const int g1 = g + step; const bool n1 = g1 < hi;
        if (n1) { ja = cv_decode(a, ws, g1); jb = cv_decode(a, ws, g1 + 1 < hi ? g1 + 1 : g1); cv_load(ja, wa, lane); cv_load(jb, wb, lane); }
        cv_finish(ia, va, scr, lane); if (g + 1 < hi) cv_finish(ib, vb, scr, lane);
        if (!n1) break;
        const int g2 = g1 + step; const bool n2 = g2 < hi;
        if (n2) { ia = cv_decode(a, ws, g2); ib = cv_decode(a, ws, g2 + 1 < hi ? g2 + 1 : g2); cv_load(ia, va, lane); cv_load(ib, vb, lane); }
        cv_finish(ja, wa, scr, lane); if (g1 + 1 < hi) cv_finish(jb, wb, scr, lane);
        if (!n2) break;
        g = g2;
    }
}
__device__ __forceinline__ void p_prologue(const Args& a, unsigned char* ws, Frame& F) {
    const int lane = opaque_tid() & 63;
    LAS float* scr = (LAS float*)(F.lds + RING_OFF + F.wave * 16384);
    const int gw = F.vcu * NWAVES + F.wave, NGW = F.G * NWAVES;
    cv_range(a, ws, 0, F.G == 256 ? CV_PRO : CV_TOTAL, gw, NGW, scr, lane);
    {
        float* wft = (float*)(ws + WS_WFT);
        for (int idx = gw * 64 + lane; idx < 2 * 16 * 2048; idx += NGW * 64) {
            const int j = idx >> 15, h = (idx >> 11) & 15, k = idx & 2047;
            wft[idx] = GIN(a, 8)[((size_t)j * DMODEL + k) * WIN_LD + NQKV + h] * GIN(a, 5)[(size_t)(2 * j + 1) * DMODEL + k];
        }
    }
    if (gw == 0) {
        float* gqk = (float*)(ws + WS_GQK);
        for (int idx = lane; idx < 512; idx += 64) { const int j = idx >> 8, w = (idx >> 7) & 1, d = idx & 127; gqk[idx] = w ? GIN(a, 11)[j * HDIM + d] : GIN(a, 10)[j * HDIM + d] * fox::QSCALE; }
        for (int j = 0; j < 2; ++j) {
            float aq = fmaxf(fabsf(GIN(a, 10)[j * HDIM + lane]), fabsf(GIN(a, 10)[j * HDIM + lane + 64])), ak = fmaxf(fabsf(GIN(a, 11)[j * HDIM + lane]), fabsf(GIN(a, 11)[j * HDIM + lane + 64]));
#pragma unroll
            for (int o = 32; o > 0; o >>= 1) { aq = fmaxf(aq, shfl_idx(aq, lane ^ o)); ak = fmaxf(ak, shfl_idx(ak, lane ^ o)); }
            if (lane == 0) gqk[512 + j] = 150.5f + 2.0f * (fox::LOG2E * 11.313708499f * 1.02f) * aq * ak;
        }
    }
    {
        bf16* XB = (bf16*)(ws + WS_XG); float* SSQ = (float*)(ws + WS_SSQ);
        for (int m = gw; m < M; m += NGW) {
            const GAS f32x4* xr = (const GAS f32x4*)(GIN(a, 0) + (size_t)m * DMODEL) + lane;
            f32x4 v[8]; float s = 0.f;
#pragma unroll
            for (int j = 0; j < 8; ++j) { v[j] = xr[64 * j]; s += (v[j].x * v[j].x + v[j].y * v[j].y) + (v[j].z * v[j].z + v[j].w * v[j].w); }
            s = wave_sum(s, lane);
            GAS u64_t* o8 = (GAS u64_t*)(XB + (size_t)m * DMODEL) + lane;
#pragma unroll
            for (int j = 0; j < 8; ++j) o8[64 * j] = (u64_t)pk2(v[j].x, v[j].y) | ((u64_t)pk2(v[j].z, v[j].w) << 32);
            if (lane < 32) SSQ[(size_t)m * 32 + lane] = lane == 0 ? s : 0.f;
        }
    }
}

template <int W, int NOUT> __device__ __forceinline__ void diff_rows(const bf16* colp, bf16* outp, const LAS float* rs_, int tb, int bs) {
    constexpr int NR = W - 1 + NOUT;
    bf16x8 raw[NR];
#pragma unroll
    for (int j = 0; j < NR; ++j) { const int r = tb - (W - 1) + j; raw[j] = (r >= bs) ? *(const bf16x8*)(colp + (size_t)r * DMODEL) : (bf16x8){0, 0, 0, 0, 0, 0, 0, 0}; }
    float s[8];
#pragma unroll
    for (int e = 0; e < 8; ++e) s[e] = 0.f;
#define HV(j, dst) do { const int r_ = tb - (W - 1) + (j); const float sc_ = (r_ >= bs) ? rs_[16 - (W - 1) + (j)] : 0.f; \
        _Pragma("unroll") for (int e_ = 0; e_ < 8; ++e_) dst[e_] = bf2f((unsigned short)raw[j][e_]) * sc_; } while (0)
#pragma unroll
    for (int j = 0; j < W - 1; ++j) { float h[8]; HV(j, h);
#pragma unroll
        for (int e = 0; e < 8; ++e) s[e] += h[e]; }
#pragma unroll
    for (int i = 0; i < NOUT; ++i) {
        const int t = tb + i; float h[8]; HV(i + W - 1, h);
#pragma unroll
        for (int e = 0; e < 8; ++e) s[e] += h[e];
        const int n = t - bs + 1; const float inv = 1.0f / (float)(n < W ? n : W);
        v4u o; o.x = pk2(s[0] * inv - h[0], s[1] * inv - h[1]); o.y = pk2(s[2] * inv - h[2], s[3] * inv - h[3]);
        o.z = pk2(s[4] * inv - h[4], s[5] * inv - h[5]); o.w = pk2(s[6] * inv - h[6], s[7] * inv - h[7]);
        *(GAS v4u*)(outp + (size_t)t * DMODEL) = o;
        float h2[8]; HV(i, h2);
#pragma unroll
        for (int e = 0; e < 8; ++e) s[e] -= h2[e];
    }
#undef HV
}
__device__ __forceinline__ void p_diff(const bf16* XG, const float* ssq, unsigned char* ws, Frame& F) {
    bf16* DIFF = (bf16*)(ws + WS_O);
    const int tid = opaque_tid();
    LAS float* rs = (LAS float*)(F.lds + RING_OFF);
    for (int v = F.vcu; v < M / 32; v += F.G) {
        const int r0 = 32 * v, bs = r0 & ~(SEQ - 1);
        if (tid < 48) {
            const int row = r0 - 16 + tid; float val = 0.f;
            if (row >= bs) { const f32x4* p = (const f32x4*)(ssq + (size_t)row * 32); float s = 0.f;
#pragma unroll
                for (int i = 0; i < 8; ++i) { const f32x4 q = p[i]; s += (q.x + q.y) + (q.z + q.w); }
                val = 1.0f / sqrtf(s * (1.0f / DMODEL) + 1e-6f); }
            rs[tid] = val;
        }
        __syncthreads();
        const int ch = tid & 255, half = tid >> 8, g = __builtin_amdgcn_readfirstlane(ch >> 6);
        const int tb = r0 + 16 * half;
        const bf16* colp = XG + ch * 8; bf16* outp = DIFF + ch * 8; const LAS float* rsb = rs + 16 * half;
#pragma unroll 1
        for (int hb = 0; hb < 2; ++hb) {
            const int t8 = tb + 8 * hb; const LAS float* r8 = rsb + 8 * hb;
            if (g == 0) diff_rows<2, 8>(colp, outp, r8, t8, bs); else if (g == 1) diff_rows<4, 8>(colp, outp, r8, t8, bs);
            else if (g == 2) diff_rows<8, 8>(colp, outp, r8, t8, bs); else diff_rows<16, 8>(colp, outp, r8, t8, bs);
        }
        __syncthreads();
    }
}

__device__ __forceinline__ void p_fgate(const Args& a, const bf16* x, const float* ssq, unsigned char* ws, Frame& F, int j) {
    const int lane = opaque_tid() & 63, rl = lane & 15, kq = lane >> 4;
    const int blk_l = F.wave >> 2, kw = F.wave & 3;
    const float* wft = (const float*)(ws + WS_WFT) + (size_t)j * 16 * 2048;
    const float* bfv = GIN(a, 9) + j * 16; float* LF = (float*)(ws + WS_LF);
    LAS float* part = (LAS float*)(F.lds + RING_OFF);
    for (int bp = F.vcu; bp < M / 32; bp += F.G) {
        const int r0 = bp * 32 + blk_l * 16;
        const bf16* xrow = x + (size_t)(r0 + rl) * DMODEL + kw * 512 + 8 * kq; const float* wrow = wft + (size_t)rl * DMODEL + kw * 512 + 8 * kq;
        f32x4 a0 = {0.f, 0.f, 0.f, 0.f}, a1 = a0, a2 = a0, a3 = a0;
#pragma unroll 8
        for (int kb = 0; kb < 16; ++kb) {
            const v4u xw = *(const v4u*)(xrow + 32 * kb);
            const f32x4 w0 = *(const f32x4*)(wrow + 32 * kb), w1 = *(const f32x4*)(wrow + 32 * kb + 4);
            a0 = __builtin_amdgcn_mfma_f32_16x16x4f32(pg8::bf_lo(xw.x), w0[0], a0, 0, 0, 0);
            a1 = __builtin_amdgcn_mfma_f32_16x16x4f32(pg8::bf_hi(xw.x), w0[1], a1, 0, 0, 0);
            a2 = __builtin_amdgcn_mfma_f32_16x16x4f32(pg8::bf_lo(xw.y), w0[2], a2, 0, 0, 0);
            a3 = __builtin_amdgcn_mfma_f32_16x16x4f32(pg8::bf_hi(xw.y), w0[3], a3, 0, 0, 0);
            a0 = __builtin_amdgcn_mfma_f32_16x16x4f32(pg8::bf_lo(xw.z), w1[0], a0, 0, 0, 0);
            a1 = __builtin_amdgcn_mfma_f32_16x16x4f32(pg8::bf_hi(xw.z), w1[1], a1, 0, 0, 0);
            a2 = __builtin_amdgcn_mfma_f32_16x16x4f32(pg8::bf_lo(xw.w), w1[2], a2, 0, 0, 0);
            a3 = __builtin_amdgcn_mfma_f32_16x16x4f32(pg8::bf_hi(xw.w), w1[3], a3, 0, 0, 0);
        }
        const float rs = pg8::row_rstd(ssq, r0 + rl, kq);
        *(LAS f32x4*)(part + (F.wave * 64 + lane) * 4) = (a0 + a1) + (a2 + a3);
        __syncthreads();
        {
            const LAS float* pp = part + (blk_l * 4 * 64 + lane) * 4 + kw;
            const float t = (pp[0] + pp[256]) + (pp[512] + pp[768]);
            const int ri = kq * 4 + kw; const float rsi = shfl_idx(rs, ri);
            const float fl = t * rsi + bfv[rl];
            const float lf = fminf(fl, 0.f) - 0.6931471805599453f * __builtin_amdgcn_logf(1.0f + __builtin_amdgcn_exp2f(-1.4426950408889634f * fabsf(fl)));
            const int row = r0 + ri, b = row >> 12, tt = row & (SEQ - 1);
            LF[((size_t)(b * NHEAD + rl)) * SEQ + tt] = lf;
        }
        __syncthreads();
    }
}

__device__ __forceinline__ void p_attn(unsigned char* ws, const float* thrp, const int vcu, const int rowpart, const int wave, char* lds) {
    const fox::bf16* Qb = (const fox::bf16*)(ws + WS_Q); const fox::bf16* Kb = (const fox::bf16*)(ws + WS_K); const fox::bf16* Vb = (const fox::bf16*)(ws + WS_V);
    fox::bf16* Ob = (fox::bf16*)(ws + WS_O); const float* LF = (const float*)(ws + WS_LF);
    const int it = rowpart ? ((((vcu >> 7) * 16 + (vcu & 15)) << 3) + 2 * ((vcu >> 5) & 3) + ((vcu >> 4) & 1)) : vcu, ltid = opaque_tid(), llane = ltid & 63;
    if (it < 256) {
        const int bh = it >> 3, s = it & 7, b = bh >> 4, h = bh & 15;
        {
            const f32x4* lf = (const f32x4*)(LF + (size_t)bh * SEQ) + 2 * ltid; const f32x4 x0 = lf[0], x1 = lf[1];
            float c[8]; c[0] = x0.x; c[1] = c[0] + x0.y; c[2] = c[1] + x0.z; c[3] = c[2] + x0.w; c[4] = c[3] + x1.x; c[5] = c[4] + x1.y; c[6] = c[5] + x1.z; c[7] = c[6] + x1.w;
            float inc = c[7];
#pragma unroll
            for (int o = 1; o < 64; o <<= 1) { const float n = shfl_idx(inc, llane - o); if (llane >= o) inc += n; }
            float* wsum = (float*)(lds + fox::LDS_WS);
            if (llane == 63) wsum[wave] = inc;
            __syncthreads();
            float off = inc - c[7];
            for (int w = 0; w < wave; ++w) off += wsum[w];
            float* Fl = (float*)(lds + fox::LDS_F) + 8 * ltid;
            *(f32x4*)Fl = (f32x4){(off + c[0]) * fox::LOG2E, (off + c[1]) * fox::LOG2E, (off + c[2]) * fox::LOG2E, (off + c[3]) * fox::LOG2E};
            *(f32x4*)(Fl + 4) = (f32x4){(off + c[4]) * fox::LOG2E, (off + c[5]) * fox::LOG2E, (off + c[6]) * fox::LOG2E, (off + c[7]) * fox::LOG2E};
            __syncthreads();
        }
#define FOX_REF(qb, jlo_) fox::BlockRef{Qb + ((size_t)bh * SEQ + (size_t)(qb) * fox::QB) * HDIM, Kb + (size_t)bh * SEQ * HDIM, Vb + (size_t)bh * SEQ * HDIM, \
                                  Ob + ((size_t)b * SEQ + (size_t)(qb) * fox::QB) * DMODEL + h * HDIM, (qb) * fox::QB, (jlo_), FOX_SKIP ? thr : -1.f}
#if FOX_SKIP
        const float thr = thrp[0];
        const float* Fa = (const float*)(lds + fox::LDS_F);
#define FOX_JLO(P0_) __builtin_amdgcn_readfirstlane((int)__builtin_ctzll(~__ballot((64 * llane + 63 < (P0_)) && (Fa[(P0_)] - Fa[64 * llane + 63] <= -thr))))
#else
#define FOX_JLO(P0_) 0
#endif
        const int qb0 = FOX_SKIP ? 2 * s : s, qb1 = FOX_SKIP ? 2 * s + 1 : 15 - s;
        const int jlo0 = FOX_JLO(qb0 * fox::QB), jlo1 = FOX_JLO(qb1 * fox::QB);
        fox::BlockRef cur = FOX_REF(qb0, jlo0);
        fox::Seam S;
        fox::fox_prime(cur, lds, S);
        for (int pass = 0; pass < 2; ++pass) {
            const fox::BlockRef nxt = (pass == 0) ? FOX_REF(qb1, jlo1) : cur;
            fox::fox_block(cur, nxt, lds, S);
            cur = nxt;
        }
#undef FOX_REF
#undef FOX_JLO
    }
}

__global__ void __launch_bounds__(NWAVES * 64, 2) mega_fwd(Args args) {
    extern __shared__ __attribute__((aligned(16))) unsigned char lds[];
    Frame F;
    F.lds = (LAS unsigned char*)lds;
    F.MISC = (volatile LAS unsigned*)(F.lds + MISC_OFF);
    F.tid = threadIdx.x; F.lane = F.tid & 63; F.wave = __builtin_amdgcn_readfirstlane(F.tid >> 6);
    F.G = gridDim.x; { const int bx = blockIdx.x; F.vcu = (F.G % 8 == 0) ? (bx % 8) * (F.G / 8) + bx / 8 : bx; }
    unsigned char* const ws0 = args.ws;
    F.ctl = (gu32*)(ws0 + WS_CTL);
    for (int u = F.tid; u < (LDS_BYTES - LDSCTL_OFF) / 4; u += NWAVES * 64) ((LAS unsigned*)(F.lds + LDSCTL_OFF))[u] = 0u;
    __syncthreads();
    XcdBarrier bar; bar.bar = (unsigned*)(F.ctl + CW_BAR); bar.x = 0; bar.st = nullptr;
    if (!MK_MULTI) bar = xcd_barrier_post((unsigned*)(F.ctl + CW_BAR), F.MISC + 8);

    const int lo = args.ph_lo, hi = args.ph_hi; int pc = 0;
#if PROBE_CLASS >= 0
    unsigned long long pr_prev = rt(), pr_acc = 0;
#if PROBE_CLASS == 10
    unsigned long long pc_prev = __builtin_amdgcn_s_memtime();
#define PH_STAMP(cls) do { const unsigned long long pc_now = __builtin_amdgcn_s_memtime(); if ((cls) == 1) pr_acc += (pc_now - pc_prev) / 20ull; pc_prev = pc_now; } while (0)
#else
#define PH_STAMP(cls) do { const unsigned long long pr_now = rt(); if ((cls) == PROBE_CLASS) pr_acc += (pr_now - pr_prev) * PROBE_AMP; pr_prev = pr_now; } while (0)
#endif
#else
#define PH_STAMP(cls) do { } while (0)
#endif
#define PH_BEGIN if (pc >= lo && pc < hi) { unsigned long long wsu_ = (unsigned long long)ws0; \
    Frame P = F; P.G = __builtin_amdgcn_readfirstlane(F.G); P.vcu = __builtin_amdgcn_readfirstlane(F.vcu); P.wave = __builtin_amdgcn_readfirstlane(F.wave); P.rowpart = __builtin_amdgcn_readfirstlane(F.rowpart); \
    int bx = P.rowpart ? P.vcu : __builtin_amdgcn_readfirstlane((int)blockIdx.x);     \
    asm volatile("" : "+s"(wsu_), "+s"(P.G), "+s"(P.vcu), "+s"(P.wave), "+s"(bx), "+s"(P.rowpart)); unsigned char* ws = (unsigned char*)(GAS unsigned char*)wsu_; \
    bf16* const XG = (bf16*)(ws + (xsel ? WS_XG2 : WS_XG)); bf16* const HACT = (bf16*)(ws + WS_HACT); float* const SSQ = (float*)(ws + (xsel ? WS_SSQ2 : WS_SSQ)); (void)XG; (void)HACT; (void)SSQ;
#define PH_FINISH(cls, glob)   PH_STAMP(cls); if (pc + 1 < hi) { if ((glob) || !P.rowpart) xcd_barrier(bar); else xcd_local_barrier(bar); } PH_STAMP(((glob) || !P.rowpart) ? 12 : 11); } ++pc;
#define PH_FINISH_DEFER(cls, glob)   PH_STAMP(cls); if (pc + 1 < hi) pend = ((glob) || !P.rowpart) ? 2 : 1; } ++pc;
#define PH_FINISH_SEL(cls, glob, defer)   PH_STAMP(cls); if (pc + 1 < hi) { if (defer) pend = ((glob) || !P.rowpart) ? 2 : 1; else if ((glob) || !P.rowpart) xcd_barrier(bar); else xcd_local_barrier(bar); } } ++pc;
#define PH_SEAM SeamBar sm{bar, pend}; pend = 0;

    F.rowpart = 0;
    int pend = 0;
    int xsel = 0;
    PH_BEGIN p_prologue(args, ws, P); PH_FINISH(0, true)
    if (!MK_MULTI) { const unsigned ev = F.MISC[10], rk = F.MISC[11];
        if (__builtin_amdgcn_readfirstlane(ev) == 1u) { F.rowpart = 1; F.vcu = (int)bar.x * 32 + (int)__builtin_amdgcn_readfirstlane(rk); } }

    for (int s = 0; s < 8; ++s) {
        const int L = s >> 1, f = s & 1;
        xsel = (s >= 1 && s <= 4) ? 1 : 0;
        PH_BEGIN
            pg8::Gemm g{XG, (const bf16*)(ws + WS_WGU + (size_t)s * SZ_WGU), M, NGU, DMODEL, DMODEL, 30, 0};
            pg8::StaticOrder S; S.init(M, NGU, P.G, bx, P.rowpart);
            pg8::EpiSwiglu E{HACT, DFF, (LAS float*)(P.lds + RTAB_OFF), SSQ};
            PH_SEAM
            pg8::gemm_phase<pg8::EpiSwiglu, pg8::StaticOrder, true, true>(P.lds + RING_OFF, g, S, E, sm);
            const bool five = P.rowpart ? (bx & 31) >= 16 : bx >= 128;
            if (P.G == 256 && five && s < 7) {
                static_assert(CV_PRO + 7 * CV_TAIL == CV_TOTAL && CV_PRO >= 2 * CV_FFN + CV_POOL, "conversion shares");
                static_assert(cv_seams_ok(), "a grid barrier must lie between every conversion share and its first reader");
                const int lo_ = CV_PRO + s * CV_TAIL, hi_ = lo_ + CV_TAIL;
                const int cw = P.rowpart ? (bx >> 5) * 16 + (bx & 31) - 16 : bx - 128;
                cv_range(args, ws, lo_, hi_, cw * NWAVES + P.wave, 128 * NWAVES, (LAS float*)(P.lds + RING_OFF + P.wave * 16384), opaque_tid() & 63);
            }
        PH_FINISH_DEFER(1, false)
        PH_BEGIN
            pg8::Gemm g{HACT, (const bf16*)(ws + WS_WD + (size_t)s * SZ_WD), M, DMODEL, DFF, DFF, 30, 0};
            pg8::StaticOrder S; S.init(M, DMODEL, P.G, bx, P.rowpart);
            pg8::EpiResid<true, false> E{XG, XG, s == 7 ? (float*)(GAS float*)args.out : nullptr, nullptr, SSQ};
            PH_SEAM
            pg8::gemm_phase<pg8::EpiResid<true, false>, pg8::StaticOrder, true, true>(P.lds + RING_OFF, g, S, E, sm);
        PH_FINISH_SEL(2, f == 1 ? s == 5 : (L & 1) == 0, f == 1)
        if (f == 0) {
            const int j = L >> 1;
            if ((L & 1) == 0) {
                PH_BEGIN p_diff(XG, SSQ, ws, P); PH_FINISH_DEFER(3, false)
                PH_BEGIN
                    pg8::Gemm g{(const bf16*)(ws + WS_O), (const bf16*)(ws + WS_WPOOL + (size_t)j * SZ_WPOOL), M, DMODEL, 512, DMODEL, 1, 1024};
                    pg8::StaticOrder S; S.init(M, DMODEL, P.G, bx, P.rowpart);
                    pg8::EpiResid<false, true> E{XG, (bf16*)(ws + (xsel ? WS_XG : WS_XG2)), nullptr, GIN(args, 7) + (size_t)j * DMODEL, (float*)(ws + (xsel ? WS_SSQ : WS_SSQ2))};
                    PH_SEAM
                    pg8::gemm_phase<pg8::EpiResid<false, true>, pg8::StaticOrder, true, true>(P.lds + RING_OFF, g, S, E, sm);
                PH_FINISH_DEFER(4, false)
            } else {
                PH_BEGIN
                    pg8::Gemm g{XG, (const bf16*)(ws + WS_WFIN + (size_t)j * SZ_WFIN), M, NQKV, DMODEL, DMODEL, 30, 0};
                    pg8::StaticOrder S; S.init(M, NQKV, P.G, bx, P.rowpart);
                    p_fgate(args, XG, SSQ, ws, P, j); PH_STAMP(9);
                    pg8::EpiQKV E{(bf16*)(ws + WS_Q), (size_t)M * DMODEL, (LAS float*)(P.lds + RTAB_OFF), (const float*)(ws + WS_GQK) + j * 256, (LAS float*)(P.lds + XCH_OFF), SSQ};
                    PH_SEAM
                    pg8::gemm_phase<pg8::EpiQKV, pg8::StaticOrder, true, true>(P.lds + RING_OFF, g, S, E, sm);
                PH_FINISH(5, true)
                PH_BEGIN p_attn(ws, (const float*)(ws + WS_GQK) + 512 + j, P.vcu, P.rowpart, P.wave, (char*)lds + RING_OFF); PH_FINISH_DEFER(7, false)
                PH_BEGIN
                    pg8::Gemm g{(const bf16*)(ws + WS_O), (const bf16*)(ws + WS_WFOUT + (size_t)j * SZ_WFOUT), M, DMODEL, DMODEL, DMODEL, 30, 0};
                    pg8::StaticOrder S; S.init(M, DMODEL, P.G, bx, P.rowpart);
                    pg8::EpiResid<false, false> E{XG, XG, nullptr, nullptr, SSQ};
                    PH_SEAM
                    pg8::gemm_phase<pg8::EpiResid<false, false>, pg8::StaticOrder, true, true>(P.lds + RING_OFF, g, S, E, sm);
                PH_FINISH_DEFER(8, false)
            }
        }
    }
#undef PH_BEGIN
#undef PH_FINISH
#undef PH_FINISH_DEFER
#undef PH_FINISH_SEL
#undef PH_SEAM
#if PROBE_CLASS >= 0
    if (blockIdx.x == 0 && F.tid == 0) { const unsigned long long t0 = rt(); while (rt() - t0 < pr_acc) __builtin_amdgcn_s_sleep(16); }
#endif
}

extern "C" void kernel_launch(void* const* d_in, const int* in_sizes, int n_in, void* d_out, int out_size, void* d_ws, size_t ws_size, hipStream_t stream) {
    static int grid = 0;
    if (grid == 0) {
        if (n_in != 17 || in_sizes[0] != M * DMODEL || out_size != M * DMODEL || ws_size < WS_END) {
            fprintf(stderr, "kernel_launch: built for 17 inputs, x and out of %d floats, >= %zu bytes of workspace; got n_in %d, in0 %d, out %d, ws %zu; nothing launched\n", M * DMODEL, (size_t)WS_END, n_in, n_in > 0 ? in_sizes[0] : -1, out_size, ws_size);
            grid = -1; return; }
        int dev = 0, cus = 0, per_cu = 0;
        if (hipGetDevice(&dev) != hipSuccess || hipDeviceGetAttribute(&cus, hipDeviceAttributeMultiprocessorCount, dev) != hipSuccess) { fprintf(stderr, "kernel_launch: device query failed\n"); grid = -1; return; }
        if (hipFuncSetAttribute((const void*)mega_fwd, hipFuncAttributeMaxDynamicSharedMemorySize, LDS_BYTES) != hipSuccess) { fprintf(stderr, "kernel_launch: hipFuncSetAttribute failed\n"); grid = -1; return; }
        if (hipOccupancyMaxActiveBlocksPerMultiprocessor(&per_cu, (const void*)mega_fwd, NWAVES * 64, LDS_BYTES) != hipSuccess || per_cu < 1)
            fprintf(stderr, "kernel_launch: note: occupancy query reports %d workgroups per CU\n", per_cu);
        (void)hipGetLastError();
        grid = cus;
    }
    if (grid < 0) return;
    if (hipMemsetAsync((char*)d_ws + WS_CTL, 0, CTL_ZERO_BYTES, stream) != hipSuccess) { fprintf(stderr, "kernel_launch: memset failed\n"); return; }
    Args a{};
    for (int i = 0; i < 17; ++i) a.in[i] = (const float*)d_in[i];
    a.out = (float*)d_out; a.ws = (unsigned char*)d_ws;
#if MK_MULTI
    for (int p = 0; p < N_PHASES; ++p) { a.ph_lo = p; a.ph_hi = p + 1; hipLaunchKernelGGL(mega_fwd, dim3(grid), dim3(NWAVES * 64), LDS_BYTES, stream, a); }
#else
    a.ph_lo = 0; a.ph_hi = N_PHASES;
    hipLaunchKernelGGL(mega_fwd, dim3(grid), dim3(NWAVES * 64), LDS_BYTES, stream, a);
#endif
    const hipError_t le = hipPeekAtLastError();
    if (le != hipSuccess) fprintf(stderr, "kernel_launch: launch failed: %s\n", hipGetErrorName(le));
}
```
